# Optimizing an MI355X kernel written in HIP

```python
import jax, jax.numpy as jnp
from jax import lax
import numpy as np

D_MODEL = 1024
BATCH = 8
SEQ = 2048
DEPTH = 4

CHUNK = 64
Q_BLOCK = 128
EPS = 1e-6

BRANCH_WIDTH = D_MODEL // 2
N_BRANCH = 4

A_HEADS = 4
A_DK = (BRANCH_WIDTH // 2) // A_HEADS
A_DV = BRANCH_WIDTH // A_HEADS
A_RANK = 16
A_GATE_NORM = 16.0

B_HEADS = 8
B_DH = BRANCH_WIDTH // B_HEADS
B_PREV_CHUNKS = 8
B_MAX_REL = 128

C_WIDTH = BRANCH_WIDTH
C_BLOCKS = 8
C_BLOCK_DIM = C_WIDTH // C_BLOCKS
C_CONV = 4
C_POW = 8.0

D_HEADS = 8
D_DH = BRANCH_WIDTH // D_HEADS

FFN_HIDDEN = -(-8 * D_MODEL // (3 * 256)) * 256

IN_SIZES = (
    A_HEADS * A_DK, A_HEADS * A_DK, A_HEADS * A_DV, A_RANK, A_HEADS * A_DV,
    B_HEADS * B_DH, B_HEADS * B_DH, B_HEADS * B_DH,
    C_WIDTH, C_WIDTH,
    D_HEADS * D_DH, D_HEADS * D_DH, D_HEADS * D_DH,
    N_BRANCH * D_MODEL,
)
IN_TOTAL = int(sum(IN_SIZES))
SPLIT_POINTS = tuple(int(v) for v in np.cumsum(IN_SIZES)[:-1])

kernel_name = 'hybrid_chunk_causal_parallel_mixer_trunk'

F32 = jnp.float32


def rmsnorm(x, g):
    xf = x.astype(F32)
    y = xf * lax.rsqrt(jnp.mean(xf * xf, axis=-1, keepdims=True) + EPS) * g.astype(F32)
    return y.astype(x.dtype)


def gla_mixer(q, k, v, r, g, w_gk, b_gk, norm_g):
    bsz, s, _ = q.shape
    nc = s // CHUNK
    gk = jax.nn.log_sigmoid((r @ w_gk + b_gk).astype(F32)) / A_GATE_NORM

    def chunks(t, d):
        return t.astype(F32).reshape(bsz, nc, CHUNK, A_HEADS, d).transpose(1, 0, 2, 3, 4)

    qc = chunks(q, A_DK) * (A_DK ** -0.5)
    kc = chunks(k, A_DK)
    vc = chunks(v, A_DV)
    cum = jnp.cumsum(chunks(gk, A_DK), axis=2)
    tot = cum[:, :, -1]
    k_dec = kc * jnp.exp(tot[:, :, None] - cum)

    def step(state, xs):
        q_c, kd_c, v_c, tot_c = xs
        state = jnp.exp(tot_c)[..., None] * state + jnp.einsum('bthk,bthv->bhkv', kd_c, v_c)
        return state, jnp.einsum('bthk,bhkv->bthv', q_c, state)

    state0 = jnp.zeros((bsz, A_HEADS, A_DK, A_DV), F32)
    _, o = lax.scan(step, state0, (qc, k_dec, vc, tot))
    o = o.transpose(1, 0, 2, 3, 4).reshape(bsz, s, A_HEADS, A_DV)
    o = rmsnorm(o, norm_g).reshape(bsz, s, A_HEADS * A_DV)
    return (o * jax.nn.silu(g.astype(F32))).astype(q.dtype)


def chunk_rel_attention(q, k, v, rel_table):
    bsz, s, _ = q.shape
    nc = s // CHUNK
    n_band = B_PREV_CHUNKS + 1
    band = n_band * CHUNK
    qc = q.reshape(bsz, nc, CHUNK, B_HEADS, B_DH)
    idx = jnp.arange(nc)[:, None] + jnp.arange(n_band)[None, :]

    def gather_band(t):
        tc = t.reshape(bsz, nc, CHUNK, B_HEADS, B_DH)
        tp = jnp.pad(tc, ((0, 0), (B_PREV_CHUNKS, 0), (0, 0), (0, 0), (0, 0)))
        return tp[:, idx].reshape(bsz, nc, band, B_HEADS, B_DH)

    kb = gather_band(k)
    vb = gather_band(v)
    sc = jnp.einsum('bnqhd,bnkhd->bhnqk', qc, kb).astype(F32) * (B_DH ** -0.5)
    qi = jnp.arange(CHUNK)[:, None]
    kj = jnp.arange(band)[None, :]
    rel = jnp.clip(B_PREV_CHUNKS * CHUNK + qi - kj, -B_MAX_REL, B_MAX_REL) + B_MAX_REL
    bias = rel_table.astype(F32)[:, rel]
    valid = (jnp.arange(nc)[:, None] - B_PREV_CHUNKS) * CHUNK + jnp.arange(band)[None, :] >= 0
    sc = jnp.where(valid[None, None, :, None, :], sc + bias[None, :, None], -1e30)
    p = jax.nn.softmax(sc, axis=-1)
    o = jnp.einsum('bhnqk,bnkhd->bnqhd', p.astype(v.dtype), vb)
    return o.reshape(bsz, s, B_HEADS * B_DH)


def rglru_mixer(gate_in, x_in, conv_w, conv_b, w_a, b_a, w_x, b_x, lam):
    bsz, s, _ = x_in.shape
    xp = jnp.pad(x_in, ((0, 0), (C_CONV - 1, 0), (0, 0)))
    xc = conv_b
    for j in range(C_CONV):
        xc = xc + xp[:, j:j + s] * conv_w[j]
    xg = xc.reshape(bsz, s, C_BLOCKS, C_BLOCK_DIM)
    r = jax.nn.sigmoid(jnp.einsum('bsgi,gij->bsgj', xg, w_a).reshape(bsz, s, C_WIDTH) + b_a)
    i = jax.nn.sigmoid(jnp.einsum('bsgi,gij->bsgj', xg, w_x).reshape(bsz, s, C_WIDTH) + b_x)
    log_a = -C_POW * r.astype(F32) * jax.nn.softplus(-lam.astype(F32))
    a = jnp.exp(log_a)
    bx = jnp.sqrt(-jnp.expm1(2.0 * log_a)) * (i * xc).astype(F32)

    def combine(left, right):
        a1, b1 = left
        a2, b2 = right
        return a1 * a2, a2 * b1 + b2

    _, h = lax.associative_scan(combine, (a, bx), axis=1)
    return jax.nn.gelu(gate_in) * h.astype(x_in.dtype)


def stick_breaking_attention(q, k, v):
    bsz, s, _ = q.shape
    qh = q.reshape(bsz, s, D_HEADS, D_DH)
    kh = k.reshape(bsz, s, D_HEADS, D_DH)
    vh = v.reshape(bsz, s, D_HEADS, D_DH)
    outs = []
    for blk in range(s // Q_BLOCK):
        end = (blk + 1) * Q_BLOCK
        z = jnp.einsum('bqhd,bkhd->bhqk', qh[:, blk * Q_BLOCK:end], kh[:, :end]).astype(F32) * (D_DH ** -0.5)
        qpos = blk * Q_BLOCK + jnp.arange(Q_BLOCK)[:, None]
        kpos = jnp.arange(end)[None, :]
        before = kpos < qpos
        log1m = jnp.where(before, jax.nn.log_sigmoid(-z), 0.0)
        tail = lax.cumsum(log1m, axis=3, reverse=True) - log1m
        att = jnp.where(before, jnp.exp(jax.nn.log_sigmoid(z) + tail), 0.0)
        outs.append(jnp.einsum('bhqk,bkhd->bqhd', att.astype(v.dtype), vh[:, :end]))
    return jnp.concatenate(outs, axis=1).reshape(bsz, s, D_HEADS * D_DH)


def setup_inputs(seed: int = 0) -> dict:
    key = jax.random.key(seed)
    ks = jax.random.split(key, 24)
    L = DEPTH

    def nrm(k, shape, scale):
        return jax.random.normal(k, shape, F32) * scale

    a0 = jax.random.uniform(ks[13], (L, C_WIDTH), F32, 0.9, 0.999)
    u = a0 ** (1.0 / C_POW)
    c_lambda = jnp.log(u) - jnp.log1p(-u)
    return {
        'x': nrm(ks[0], (BATCH, SEQ, D_MODEL), 1.0),
        'norm_mix': 1.0 + nrm(ks[1], (L, D_MODEL), 0.02),
        'w_in': nrm(ks[2], (L, D_MODEL, IN_TOTAL), D_MODEL ** -0.5),
        'a_w_gk': nrm(ks[3], (L, A_RANK, A_HEADS * A_DK), A_RANK ** -0.5),
        'a_b_gk': nrm(ks[4], (L, A_HEADS * A_DK), 0.1),
        'a_norm': 1.0 + nrm(ks[5], (L, A_DV), 0.02),
        'b_rel_bias': nrm(ks[6], (L, B_HEADS, 2 * B_MAX_REL + 1), 0.1),
        'c_conv_w': nrm(ks[7], (L, C_CONV, C_WIDTH), C_CONV ** -0.5),
        'c_conv_b': nrm(ks[8], (L, C_WIDTH), 0.01),
        'c_w_a': nrm(ks[9], (L, C_BLOCKS, C_BLOCK_DIM, C_BLOCK_DIM), C_BLOCK_DIM ** -0.5),
        'c_b_a': nrm(ks[10], (L, C_WIDTH), 0.01),
        'c_w_x': nrm(ks[11], (L, C_BLOCKS, C_BLOCK_DIM, C_BLOCK_DIM), C_BLOCK_DIM ** -0.5),
        'c_b_x': nrm(ks[12], (L, C_WIDTH), 0.01),
        'c_lambda': c_lambda,
        'w_branch': nrm(ks[14], (L, N_BRANCH, BRANCH_WIDTH, D_MODEL), BRANCH_WIDTH ** -0.5),
        'w_out': nrm(ks[15], (L, D_MODEL, D_MODEL), D_MODEL ** -0.5),
        'norm_ffn': 1.0 + nrm(ks[16], (L, D_MODEL), 0.02),
        'w_ffn_gate': nrm(ks[17], (L, D_MODEL, FFN_HIDDEN), D_MODEL ** -0.5),
        'w_ffn_up': nrm(ks[18], (L, D_MODEL, FFN_HIDDEN), D_MODEL ** -0.5),
        'w_ffn_down': nrm(ks[19], (L, FFN_HIDDEN, D_MODEL), FFN_HIDDEN ** -0.5),
        'norm_final': 1.0 + nrm(ks[20], (D_MODEL,), 0.02),
    }


def reference(x, norm_mix, w_in, a_w_gk, a_b_gk, a_norm, b_rel_bias, c_conv_w, c_conv_b,
              c_w_a, c_b_a, c_w_x, c_b_x, c_lambda, w_branch, w_out, norm_ffn,
              w_ffn_gate, w_ffn_up, w_ffn_down, norm_final):
    bsz, s, _ = x.shape
    h = x
    for l in range(DEPTH):
        xn = rmsnorm(h, norm_mix[l])
        proj = xn @ w_in[l]
        (a_q, a_k, a_v, a_r, a_g, b_q, b_k, b_v, c_g, c_x,
         d_q, d_k, d_v, gate_logits) = jnp.split(proj, SPLIT_POINTS, axis=-1)

        y_a = gla_mixer(a_q, a_k, a_v, a_r, a_g, a_w_gk[l], a_b_gk[l], a_norm[l])
        y_b = chunk_rel_attention(b_q, b_k, b_v, b_rel_bias[l])
        y_c = rglru_mixer(c_g, c_x, c_conv_w[l], c_conv_b[l], c_w_a[l], c_b_a[l],
                          c_w_x[l], c_b_x[l], c_lambda[l])
        y_d = stick_breaking_attention(d_q, d_k, d_v)

        branches = jnp.stack([y_a, y_b, y_c, y_d], axis=2)
        widened = jnp.einsum('bsnw,nwd->bsnd', branches, w_branch[l])
        gates = jax.nn.sigmoid(gate_logits).reshape(bsz, s, N_BRANCH, D_MODEL)
        mixed = jnp.sum(gates * widened, axis=2)
        h = h + mixed @ w_out[l]

        hn = rmsnorm(h, norm_ffn[l])
        h = h + (jax.nn.silu(hn @ w_ffn_gate[l]) * (hn @ w_ffn_up[l])) @ w_ffn_down[l]
    return rmsnorm(h, norm_final)
```

```cpp
#include <hip/hip_runtime.h>
#include <hip/hip_cooperative_groups.h>
#include <cstdio>
#include <cstdint>
namespace cg = cooperative_groups;

#define LAS __attribute__((address_space(3)))
typedef unsigned short bf16_t;
typedef short bf16x8 __attribute__((ext_vector_type(8)));
typedef float f32x4 __attribute__((ext_vector_type(4)));
typedef float f32x16 __attribute__((ext_vector_type(16)));
typedef unsigned u32x4 __attribute__((ext_vector_type(4)));
typedef unsigned u32x2 __attribute__((ext_vector_type(2)));
typedef float f32x2 __attribute__((ext_vector_type(2)));
typedef __bf16 bf16x2_t __attribute__((ext_vector_type(2)));
#define DI __device__ __forceinline__

constexpr int T = 16384, SEQ = 2048, DM = 1024, NL = 4;
constexpr int NORIG = 9744, NIN = 9984, LD1 = 5888, LD2 = 4096, FF = 2816, NGU = 5632;
constexpr int A_Q = 0, A_K = 256, A_V = 512, A_GK = 1024, A_G = 1280, B_Q = 1792, B_K = 2304, B_V = 2816, C_G = 3328, C_X = 3840, D_Q = 4352, D_K = 4864, D_V = 5376;
constexpr float EPS = 1e-6f;
constexpr size_t WS_CTL = 0, WS_SS = 4096, WS_W1 = 1u << 20;
constexpr size_t SZ_W1 = (size_t)NIN * DM * 2, SZ_WB = (size_t)4 * DM * 512 * 2, SZ_WO = (size_t)DM * DM * 2, SZ_WGU = (size_t)NGU * DM * 2, SZ_WD = (size_t)DM * FF * 2;
constexpr size_t WS_WB = WS_W1 + NL * SZ_W1, WS_WO = WS_WB + NL * SZ_WB, WS_WGU = WS_WO + NL * SZ_WO, WS_WD = WS_WGU + NL * SZ_WGU;
constexpr size_t WS_P1 = WS_WD + NL * SZ_WD, WS_P2 = WS_P1 + (size_t)T * LD1 * 2, WS_Y = WS_P2 + (size_t)T * LD2 * 2, WS_HB = WS_Y + (size_t)4 * T * 512 * 2, WS_SSP = WS_HB + (size_t)T * DM * 2, WS_END = WS_SSP + (size_t)9 * T * 64;
static_assert(WS_END <= 638582784ull, "workspace");
constexpr int LDS_BYTES = 147456, JOBSLOT = 140000, XBST = 140016, RS_OFF = 131072;
constexpr size_t WS_BAR = 4096, CTL_ZERO_BYTES = 32768;
#ifndef REP_MIX
#define REP_MIX 1
#endif
#ifndef REP_G1
#define REP_G1 1
#endif
#ifndef REP_G3
#define REP_G3 1
#endif
#ifndef REP_G5
#define REP_G5 1
#endif
#ifndef REP_P0
#define REP_P0 1
#endif

DI int opaque_tid() { int t = threadIdx.x; asm volatile("" : "+v"(t)); return t; }
DI unsigned pk2(float lo, float hi) { f32x2 v = {lo, hi}; bf16x2_t b = __builtin_convertvector(v, bf16x2_t); return __builtin_bit_cast(unsigned, b); }
DI float bflo(unsigned w) { return __uint_as_float(w << 16); }
DI float bfhi(unsigned w) { return __uint_as_float(w & 0xffff0000u); }
DI float bf2f(bf16_t v) { return __uint_as_float((unsigned)v << 16); }
DI bf16_t f2bf(float f) { return (bf16_t)(pk2(f, 0.f) & 0xffffu); }
DI float ss_row(const float* ssp, int row) { const f32x4* sp = (const f32x4*)(ssp + (size_t)row * 16); float s = 0.f;
#pragma unroll
    for (int q = 0; q < 4; ++q) { const f32x4 v = sp[q]; s += (v[0] + v[1]) + (v[2] + v[3]); } return s; }
DI int crow(int r, int hi) { return (r & 3) + 8 * (r >> 2) + 4 * hi; }
DI float sigmoidf_(float x) { return 1.f / (1.f + __expf(-x)); }
#define MFMA32(a, b, c) __builtin_amdgcn_mfma_f32_32x32x16_bf16((a), (b), (c), 0, 0, 0)


#define XB_TMO      128
#define XB_XCNT(j)  (256  + 64 * (j))
#define XB_XSUB(j)  (1280 + 64 * (j))
#define XB_XGEN(j)  (2304 + 64 * (j))
#define XB_TOP      3328
#define XB_TOPGEN   3392
#define XCD_BAR_WORDS 3456
#define XB_SPIN_CAP (1u << 22)
DI unsigned xb_ld(unsigned* p)              { return __hip_atomic_load(p, __ATOMIC_RELAXED, __HIP_MEMORY_SCOPE_AGENT); }
DI unsigned xb_add(unsigned* p, unsigned v) { return __hip_atomic_fetch_add(p, v, __ATOMIC_RELAXED, __HIP_MEMORY_SCOPE_AGENT); }
DI unsigned xb_xcc_id() { return (unsigned)__builtin_amdgcn_s_getreg((3 << 11) | 20) & 0xFu; }
#define XB_SPIN(cond, bar) do { unsigned _sp = 0; while (cond) { __builtin_amdgcn_s_sleep(1); \
    if ((++_sp & 255u) == 0u) { if (xb_ld(&(bar)[XB_TMO])) break; if (_sp > XB_SPIN_CAP) { atomicAdd(&(bar)[XB_TMO], 1u); break; } } } } while (0)
struct XcdBarrier { unsigned* bar; unsigned x; volatile LAS unsigned* st; };
DI XcdBarrier xcd_barrier_post(unsigned* bar, volatile LAS unsigned* st) {
    XcdBarrier b; b.bar = bar; b.x = xb_xcc_id(); b.st = st;
    if (threadIdx.x == 0) (void)xb_add(&bar[XB_XCNT(b.x)], 1u);
    return b;
}
DI void xcd_barrier_complete(unsigned* bar, unsigned x, unsigned& nloc, unsigned& nx) {
    const unsigned G = gridDim.x * gridDim.y * gridDim.z;
    unsigned sum, cnt, mine, sp = 0u;
    for (;;) {
        sum = 0u; cnt = 0u; mine = 0u;
#pragma unroll
        for (unsigned j = 0; j < 16; ++j) { const unsigned c = xb_ld(&bar[XB_XCNT(j)]); sum += c; cnt += (c > 0u) ? 1u : 0u; mine = (j == x) ? c : mine; }
        if (sum == G) break;
        __builtin_amdgcn_s_sleep(1);
        if ((++sp & 255u) == 0u) { if (xb_ld(&bar[XB_TMO])) break; if (sp > XB_SPIN_CAP) { atomicAdd(&bar[XB_TMO], 1u); break; } }
    }
    nloc = mine > 0u ? mine : 1u; nx = cnt > 0u ? cnt : 1u;
}
DI void xcd_barrier(const XcdBarrier& b) {
    asm volatile("s_waitcnt vmcnt(0)" ::: "memory");
    __syncthreads();
    if (threadIdx.x == 0) {
        unsigned* bar = b.bar;
        __builtin_amdgcn_s_waitcnt(0);
        unsigned nloc = b.st[0], nx = b.st[1];
        if (nloc == 0u) { xcd_barrier_complete(bar, b.x, nloc, nx); b.st[0] = nloc; b.st[1] = nx; }
        const unsigned old = xb_add(&bar[XB_XSUB(b.x)], 1u);
        const unsigned gen = old / nloc;
        if (old + 1u == (gen + 1u) * nloc) {
            __builtin_amdgcn_fence(__ATOMIC_RELEASE, "agent");
            asm volatile("s_waitcnt vmcnt(0)" ::: "memory");
            const unsigned og = xb_add(&bar[XB_TOP], 1u);
            const unsigned tg = og / nx;
            if (og + 1u == (tg + 1u) * nx) xb_add(&bar[XB_TOPGEN], 1u);
            else XB_SPIN(xb_ld(&bar[XB_TOPGEN]) == tg, bar);
            __builtin_amdgcn_fence(__ATOMIC_ACQUIRE, "agent");
            xb_add(&bar[XB_XGEN(b.x)], 1u);
            asm volatile("s_waitcnt vmcnt(0)" ::: "memory");
        } else {
            XB_SPIN(xb_ld(&bar[XB_XGEN(b.x)]) == gen, bar);
            __builtin_amdgcn_fence(__ATOMIC_ACQUIRE, "agent");
            asm volatile("s_waitcnt vmcnt(0)" ::: "memory");
        }
    }
    __syncthreads();
}

namespace pg8 {
constexpr int BM = 256, BK = 64, HALF = 128, HTB = HALF * BK * 2, NXCD = 8, WGM = 8;
DI int lds_byte(int r, int c) { const int st = (r >> 4) * 2 + (c >> 5), rr = r & 15, cc = c & 31, ob = rr * 64 + cc * 2; return st * 1024 + (ob ^ (((ob >> 9) & 1) << 5)); }
DI void stage_rc(int b, int& R, int& C) { const int st = b / 1024, sb = b % 1024, swz = sb ^ (((sb >> 9) & 1) << 5); R = (st >> 1) * 16 + swz / 64; C = (st & 1) * 32 + (swz % 64) / 2; }
DI int perm32(int rho) { const int n = rho >> 4, i = rho & 15; return 8 * (i >> 2) + 4 * n + (i & 3); }

struct Unit { int pm, pn, br; };
struct Gemm { const bf16_t* A; const bf16_t* Bt; int M, N, K; size_t brA, brB; int nbr; };

struct StaticOrder {
    int nN, nwg, G, c, sh;
    DI void init(int M, int N, int G_, int c_, int nbr_) { nN = N / BM; nwg = (M / BM) * nN; G = G_; c = c_; sh = nbr_ == 4 ? 2 : 0; }
    DI bool next(int i, Unit& u) const {
        const int ti = i >> sh; u.br = i & ((1 << sh) - 1);
        const int L = ti * G + c; if (L >= nwg) return false;
        int wgid = L; { const int q = nwg / NXCD, r = nwg % NXCD, xcd = wgid % NXCD, off = wgid / NXCD; wgid = (xcd < r ? xcd * (q + 1) : r * (q + 1) + (xcd - r) * q) + off; }
        const int nig = WGM * nN, gid = wgid / nig, rem = wgid - gid * nig;
        u.pm = gid * WGM + (rem & 7); u.pn = rem >> 3; return true;
    }
};

template <class Epi, bool ALIGN_EPI>
DI void gemm_phase(LAS unsigned char* lds, const Gemm g, const StaticOrder& S, const Epi& E) {
    const int tid = opaque_tid(), wid = __builtin_amdgcn_readfirstlane(tid >> 6), lane = tid & 63, wr = wid >> 2, wc = wid & 3, fr = lane & 15, fq = lane >> 4;
    const int K = g.K, nt = K / BK;
    unsigned voffA[2], voffB[2];
#pragma unroll
    for (int i = 0; i < 2; ++i) { int R, C; stage_rc(tid * 16 + i * 8192, R, C); const int Rb = Epi::PERM ? ((R & ~31) + perm32(R & 31)) : R;
        voffA[i] = (unsigned)(R * K + C) * 2u; voffB[i] = (unsigned)(Rb * K + C) * 2u; }
    const size_t kstep = (size_t)(BK * 2);
    const size_t hstep = (size_t)HALF * K * 2;
    const size_t tstep = 2 * hstep;
    const unsigned ldsw = (unsigned)wid * 1024u;
    const int aoff = lds_byte(wr * 64 + fr, fq * 8), boff = lds_byte(wc * 32 + fr, fq * 8);
#define PG8_SA(b, h) (((b) * 2 + (h)) * HTB)
#define PG8_SB(b, h) ((4 + (b) * 2 + (h)) * HTB)
#define PG8_STAGE(bufoff, gbase, voff) do { _Pragma("unroll") for (int _i = 0; _i < 2; ++_i) \
        __builtin_amdgcn_global_load_lds((const unsigned*)((const char*)(gbase) + (voff)[_i]), (LAS unsigned*)(lds + (bufoff) + ldsw + _i * 8192), 16, 0, 0); } while (0)
#define PG8_LDA(dst, b, h) do { _Pragma("unroll") for (int m = 0; m < 4; ++m) _Pragma("unroll") for (int k = 0; k < 2; ++k) dst[m][k] = *(const LAS bf16x8*)(lds + PG8_SA(b, h) + aoff + m * 2048 + k * 1024); } while (0)
#define PG8_LDB(dst, b, h) do { _Pragma("unroll") for (int n = 0; n < 2; ++n) _Pragma("unroll") for (int k = 0; k < 2; ++k) dst[n][k] = *(const LAS bf16x8*)(lds + PG8_SB(b, h) + boff + n * 2048 + k * 1024); } while (0)
#define PG8_MMA(ai, bj, At, Bt) do { __builtin_amdgcn_s_setprio(1); _Pragma("unroll") for (int m = 0; m < 4; ++m) _Pragma("unroll") for (int n = 0; n < 2; ++n) _Pragma("unroll") for (int k = 0; k < 2; ++k) \
        acc[ai][bj][m][n] = __builtin_amdgcn_mfma_f32_16x16x32_bf16(Bt[n][k], At[m][k], acc[ai][bj][m][n], 0, 0, 0); __builtin_amdgcn_s_setprio(0); } while (0)
#define PG8_WAIT_V(n) asm volatile("s_waitcnt vmcnt(" #n ")" ::: "memory")
#define PG8_WAIT_L(n) asm volatile("s_waitcnt lgkmcnt(" #n ")" ::: "memory")
#define PG8_BAR __builtin_amdgcn_s_barrier()
#define PG8_SCHED __builtin_amdgcn_sched_barrier(0)
#define PG8_ZERO() do { _Pragma("unroll") for (int a = 0; a < 2; ++a) _Pragma("unroll") for (int b = 0; b < 2; ++b) _Pragma("unroll") for (int m = 0; m < 4; ++m) _Pragma("unroll") for (int n = 0; n < 2; ++n) acc[a][b][m][n] = (f32x4){0.f, 0.f, 0.f, 0.f}; } while (0)
    Unit cur, nxt; int ui = 0;
    if (!S.next(0, cur)) return;
    f32x4 acc[2][2][4][2];
    if constexpr (Epi::INIT) E.init(acc, cur, wr, wc, fr, fq); else PG8_ZERO();
    bf16x8 At[4][2], B0[2][2], B1[2][2];
    const char* cA = (const char*)g.A + (size_t)cur.pm * tstep + (size_t)cur.br * g.brA; const char* cB = (const char*)g.Bt + (size_t)cur.pn * tstep + (size_t)cur.br * g.brB;
    PG8_STAGE(PG8_SB(0, 0), cB, voffB); PG8_STAGE(PG8_SB(0, 1), cB + hstep, voffB); PG8_STAGE(PG8_SA(0, 0), cA, voffA); PG8_STAGE(PG8_SA(0, 1), cA + hstep, voffA);
    if (wr == 1) PG8_BAR;
    PG8_WAIT_V(2); PG8_BAR;
    PG8_STAGE(PG8_SB(1, 0), cB + kstep, voffB); PG8_STAGE(PG8_SA(1, 0), cA + kstep, voffA); PG8_STAGE(PG8_SB(1, 1), cB + hstep + kstep, voffB);
    PG8_WAIT_V(6); PG8_BAR;
    for (;;) {
        const bool has_next = S.next(ui + 1, nxt);
        const char* nA = has_next ? (const char*)g.A + (size_t)nxt.pm * tstep + (size_t)nxt.br * g.brA : cA; const char* nB = has_next ? (const char*)g.Bt + (size_t)nxt.pn * tstep + (size_t)nxt.br * g.brB : cB;
        for (int t = 0; t < nt; t += 2) {
            const bool last = (t == nt - 2);
            const char* a1 = cA + (size_t)(t + 1) * kstep;
            const char* a2 = last ? nA : cA + (size_t)(t + 2) * kstep; const char* b2 = last ? nB : cB + (size_t)(t + 2) * kstep;
            const char* a3 = a2 + kstep; const char* b3 = b2 + kstep;
            PG8_LDB(B0, 0, 0); PG8_LDB(B1, 0, 1); PG8_SCHED; PG8_LDA(At, 0, 0); PG8_STAGE(PG8_SA(1, 1), a1 + hstep, voffA);
            PG8_WAIT_V(8); PG8_WAIT_L(0); PG8_BAR; PG8_MMA(0, 0, At, B0); PG8_MMA(0, 1, At, B1); PG8_BAR; PG8_SCHED;
            PG8_LDA(At, 0, 1); PG8_STAGE(PG8_SB(0, 0), b2, voffB); PG8_STAGE(PG8_SB(0, 1), b2 + hstep, voffB); PG8_STAGE(PG8_SA(0, 0), a2, voffA);
            PG8_WAIT_V(8); PG8_WAIT_L(0); PG8_BAR; PG8_MMA(1, 0, At, B0); PG8_MMA(1, 1, At, B1); PG8_BAR; PG8_SCHED;
            PG8_LDB(B0, 1, 0); PG8_LDB(B1, 1, 1); PG8_SCHED; PG8_LDA(At, 1, 0); PG8_STAGE(PG8_SA(0, 1), a2 + hstep, voffA);
            PG8_WAIT_V(8); PG8_WAIT_L(0); PG8_BAR; PG8_MMA(0, 0, At, B0); PG8_MMA(0, 1, At, B1); PG8_BAR; PG8_SCHED;
            PG8_LDA(At, 1, 1); PG8_STAGE(PG8_SB(1, 0), b3, voffB); PG8_STAGE(PG8_SB(1, 1), b3 + hstep, voffB); PG8_STAGE(PG8_SA(1, 0), a3, voffA);
            PG8_WAIT_V(8); PG8_WAIT_L(0); PG8_BAR; PG8_MMA(1, 0, At, B0); PG8_MMA(1, 1, At, B1); PG8_BAR; PG8_SCHED;
        }
        if constexpr (ALIGN_EPI) { if (wr == 0) PG8_BAR; }
        E(acc, cur, wr, wc, fr, fq);
        if (!has_next) break;
        if constexpr (Epi::INIT) E.init(acc, nxt, wr, wc, fr, fq); else if (!(Epi::MULTI && nxt.br != 0)) PG8_ZERO();
        cur = nxt; cA = nA; cB = nB; ++ui;
        if constexpr (ALIGN_EPI) { if (wr == 1) PG8_BAR; }
    }
    PG8_WAIT_V(0);
    if constexpr (!ALIGN_EPI) { if (wr == 0) PG8_BAR; }
    PG8_BAR;
#undef PG8_SA
#undef PG8_SB
#undef PG8_STAGE
#undef PG8_LDA
#undef PG8_LDB
#undef PG8_MMA
#undef PG8_WAIT_V
#undef PG8_WAIT_L
#undef PG8_BAR
#undef PG8_SCHED
#undef PG8_ZERO
}

struct EpiProj {
    static constexpr bool PERM = true, MULTI = false, INIT = false;
    bf16_t* P1; bf16_t* P2; const LAS float* rst;
    DI void operator()(f32x4 (&acc)[2][2][4][2], const Unit& u, int wr, int wc, int fr, int fq) const {
        const int row0 = u.pm * BM + wr * 64 + fr;
        bf16_t* base; int ldc, colt;
        if (u.pn < 23) { base = P1; ldc = LD1; colt = u.pn * BM; } else { base = P2; ldc = LD2; colt = (u.pn - 23) * BM; }
        const int col0 = colt + wc * 64 + 8 * fq;
#pragma unroll
        for (int ai = 0; ai < 2; ++ai)
#pragma unroll
            for (int m = 0; m < 4; ++m) { const int row = row0 + ai * HALF + m * 16; const float rs = rst[row & 2047];
                bf16_t* rowp = base + (size_t)row * ldc + col0;
                if (u.pn >= 23) {
                    u32x4 wq;
#pragma unroll
                    for (int bj = 0; bj < 2; ++bj) { const f32x4 v0 = acc[ai][bj][m][0] * rs, v1 = acc[ai][bj][m][1] * rs; unsigned q0 = 0u, q1 = 0u;
#pragma unroll
                        for (int e = 0; e < 4; ++e) {
                            const unsigned a = (unsigned)fmaxf(__builtin_amdgcn_rcpf(1.f + __expf(-v0[e])) * 255.f + 0.5f, 1.f), b = (unsigned)fmaxf(__builtin_amdgcn_rcpf(1.f + __expf(-v1[e])) * 255.f + 0.5f, 1.f);
                            q0 |= a << (8 * e); q1 |= b << (8 * e); }
                        if (bj == 0) { wq.x = q0; wq.y = q1; } else { wq.z = q0; wq.w = q1; } }
                    *(u32x4*)((unsigned char*)P2 + (size_t)row * LD2 + (u.pn - 23) * BM + wc * 64 + 16 * fq) = wq;
                } else {
#pragma unroll
                for (int bj = 0; bj < 2; ++bj) { const f32x4 v0 = acc[ai][bj][m][0] * rs, v1 = acc[ai][bj][m][1] * rs;
                    u32x4 w; w.x = pk2(v0[0], v0[1]); w.y = pk2(v0[2], v0[3]); w.z = pk2(v1[0], v1[1]); w.w = pk2(v1[2], v1[3]);
                    *(u32x4*)(rowp + bj * 32) = w; } } }
    }
};
struct EpiMerge {
    static constexpr bool PERM = true, MULTI = true, INIT = false;
    const bf16_t* P2; bf16_t* MX;
    DI void operator()(f32x4 (&acc)[2][2][4][2], const Unit& u, int wr, int wc, int fr, int fq) const {
        const int row0 = u.pm * BM + wr * 64 + fr, col0 = u.pn * BM + wc * 64 + 8 * fq, br = u.br;
#pragma unroll
        for (int ai = 0; ai < 2; ++ai)
#pragma unroll
            for (int m = 0; m < 4; ++m) { const int row = row0 + ai * HALF + m * 16;
                const unsigned char* gp = (const unsigned char*)P2 + (size_t)row * LD2 + br * 1024 + u.pn * BM + wc * 64 + 16 * fq;
                const u32x4 ga = *(const u32x4*)gp; u32x4 gb = ga; if (br < 3) gb = *(const u32x4*)(gp + 1024);
#pragma unroll
                for (int bj = 0; bj < 2; ++bj) { const int col = col0 + bj * 32;
                    float f[8];
#pragma unroll
                    for (int e = 0; e < 8; ++e) { const float a_ = (float)((ga[2 * bj + (e >> 2)] >> (8 * (e & 3))) & 0xffu);
                        f[e] = br < 3 ? a_ * __builtin_amdgcn_rcpf((float)((gb[2 * bj + (e >> 2)] >> (8 * (e & 3))) & 0xffu)) : a_ * (1.f / 255.f); }
                    f32x4 v0 = acc[ai][bj][m][0], v1 = acc[ai][bj][m][1];
                    v0[0] *= f[0]; v0[1] *= f[1]; v0[2] *= f[2]; v0[3] *= f[3]; v1[0] *= f[4]; v1[1] *= f[5]; v1[2] *= f[6]; v1[3] *= f[7];
                    acc[ai][bj][m][0] = v0; acc[ai][bj][m][1] = v1;
                    if (br == 3) { u32x4 w; w.x = pk2(v0[0], v0[1]); w.y = pk2(v0[2], v0[3]); w.z = pk2(v1[0], v1[1]); w.w = pk2(v1[2], v1[3]);
                        *(u32x4*)(MX + (size_t)row * DM + col) = w; } } }
    }
};
struct EpiResid {
    static constexpr bool PERM = true, MULTI = false, INIT = true;
    const float* rin32; const bf16_t* lin; float* hout32; bf16_t* lout; bf16_t* hb; float* ssn;
    DI void init(f32x4 (&acc)[2][2][4][2], const Unit& u, int wr, int wc, int fr, int fq) const {
        const int row0 = u.pm * BM + wr * 64 + fr, col0 = u.pn * BM + wc * 64 + 8 * fq;
#pragma unroll
        for (int ai = 0; ai < 2; ++ai)
#pragma unroll
            for (int m = 0; m < 4; ++m)
#pragma unroll
                for (int bj = 0; bj < 2; ++bj) { const size_t o = (size_t)(row0 + ai * HALF + m * 16) * DM + col0 + bj * 32;
                    if (rin32) { acc[ai][bj][m][0] = *(const f32x4*)(rin32 + o); acc[ai][bj][m][1] = *(const f32x4*)(rin32 + o + 4); }
                    else { const u32x4 hi = *(const u32x4*)(hb + o), lo = *(const u32x4*)(lin + o);
                        acc[ai][bj][m][0] = (f32x4){bflo(hi.x) + bflo(lo.x), bfhi(hi.x) + bfhi(lo.x), bflo(hi.y) + bflo(lo.y), bfhi(hi.y) + bfhi(lo.y)};
                        acc[ai][bj][m][1] = (f32x4){bflo(hi.z) + bflo(lo.z), bfhi(hi.z) + bfhi(lo.z), bflo(hi.w) + bflo(lo.w), bfhi(hi.w) + bfhi(lo.w)}; } }
    }
    DI void operator()(f32x4 (&acc)[2][2][4][2], const Unit& u, int wr, int wc, int fr, int fq) const {
        const int row0 = u.pm * BM + wr * 64 + fr, col0 = u.pn * BM + wc * 64 + 8 * fq;
#pragma unroll
        for (int ai = 0; ai < 2; ++ai)
#pragma unroll
            for (int m = 0; m < 4; ++m) { const int row = row0 + ai * HALF + m * 16; float sq = 0.f;
#pragma unroll
                for (int bj = 0; bj < 2; ++bj) { const size_t o = (size_t)row * DM + col0 + bj * 32;
                    const f32x4 v0 = acc[ai][bj][m][0], v1 = acc[ai][bj][m][1];
                    u32x4 w; w.x = pk2(v0[0], v0[1]); w.y = pk2(v0[2], v0[3]); w.z = pk2(v1[0], v1[1]); w.w = pk2(v1[2], v1[3]);
                    *(u32x4*)(hb + o) = w;
                    if (hout32) { *(f32x4*)(hout32 + o) = v0; *(f32x4*)(hout32 + o + 4) = v1; }
                    else { u32x4 l; l.x = pk2(v0[0] - bflo(w.x), v0[1] - bfhi(w.x)); l.y = pk2(v0[2] - bflo(w.y), v0[3] - bfhi(w.y));
                        l.z = pk2(v1[0] - bflo(w.z), v1[1] - bfhi(w.z)); l.w = pk2(v1[2] - bflo(w.w), v1[3] - bfhi(w.w));
                        *(u32x4*)(lout + o) = l; }
                    sq += v0[0] * v0[0] + v0[1] * v0[1] + v0[2] * v0[2] + v0[3] * v0[3] + v1[0] * v1[0] + v1[1] * v1[1] + v1[2] * v1[2] + v1[3] * v1[3]; }
                sq += __shfl_xor(sq, 16); sq += __shfl_xor(sq, 32);
                if (fq == 0) ssn[(size_t)row * 16 + u.pn * 4 + wc] = sq; }
    }
};
struct EpiFfn {
    static constexpr bool PERM = false, MULTI = false, INIT = false;
    bf16_t* U; const LAS float* rst;
    DI void operator()(f32x4 (&acc)[2][2][4][2], const Unit& u, int wr, int wc, int fr, int fq) const {
        const int row0 = u.pm * BM + wr * 64 + fr, col = 128 * u.pn + 32 * wc + 8 * fq;
#pragma unroll
        for (int ai = 0; ai < 2; ++ai)
#pragma unroll
            for (int m = 0; m < 4; ++m) { const int row = row0 + ai * HALF + m * 16; const float rs = rst[row & 2047]; float o[8];
#pragma unroll
                for (int bj = 0; bj < 2; ++bj) { const f32x4 gg = acc[ai][bj][m][0] * rs, uu = acc[ai][bj][m][1] * rs;
#pragma unroll
                    for (int e = 0; e < 4; ++e) o[4 * bj + e] = gg[e] * __builtin_amdgcn_rcpf(1.f + __expf(-gg[e])) * uu[e]; }
                u32x4 w; w.x = pk2(o[0], o[1]); w.y = pk2(o[2], o[3]); w.z = pk2(o[4], o[5]); w.w = pk2(o[6], o[7]);
                *(u32x4*)(U + (size_t)row * FF + col) = w; }
    }
};
}

struct Params {
    const float* x; const float* norm_mix; const float* w_in; const float* a_w_gk; const float* a_b_gk; const float* a_norm; const float* b_rel; const float* c_conv_w; const float* c_conv_b;
    const float* c_w_a; const float* c_b_a; const float* c_w_x; const float* c_b_x; const float* c_lambda; const float* w_branch; const float* w_out; const float* norm_ffn;
    const float* w_gate; const float* w_up; const float* w_down; const float* norm_final; float* out; unsigned char* ws;
};

struct TrItem { const float* src; const float* ksc; bf16_t* dst; int ld, c0, k0, ldd, mode, roff; };
constexpr int TR_IN = 608, TR_BR = 128, TR_OUT = 64, TR_G = 176, TR_U = 176, TR_D = 176, TR_PER = TR_IN + TR_BR + TR_OUT + TR_G + TR_U + TR_D, TR_GK = 64;
DI TrItem tr_decode(const Params& p, int it) {
    unsigned char* ws = p.ws; TrItem t; const int l = it / TR_PER; int r = it - l * TR_PER;
    if (r < TR_IN) { const int ct = r >> 4, kt = r & 15;
        t.src = p.w_in + (size_t)l * DM * NORIG; t.ld = NORIG; t.c0 = ct < 4 ? ct * 256 : 1040 + (ct - 4) * 256; t.k0 = kt * 64; t.ksc = p.norm_mix + l * DM;
        t.dst = (bf16_t*)(ws + WS_W1 + l * SZ_W1); t.ldd = DM; t.mode = 0; t.roff = ct < 4 ? 0 : 240; return t; }
    r -= TR_IN;
    if (r < TR_BR) { const int br = r >> 5, q = r & 31, ct = q >> 3, kt = q & 7;
        t.src = p.w_branch + ((size_t)l * 4 + br) * 512 * DM; t.ld = DM; t.c0 = ct * 256; t.k0 = kt * 64; t.ksc = nullptr;
        t.dst = (bf16_t*)(ws + WS_WB + l * SZ_WB) + (size_t)br * DM * 512; t.ldd = 512; t.mode = 0; t.roff = 0; return t; }
    r -= TR_BR;
    if (r < TR_OUT) { const int ct = r >> 4, kt = r & 15;
        t.src = p.w_out + (size_t)l * DM * DM; t.ld = DM; t.c0 = ct * 256; t.k0 = kt * 64; t.ksc = nullptr; t.dst = (bf16_t*)(ws + WS_WO + l * SZ_WO); t.ldd = DM; t.mode = 0; t.roff = 0; return t; }
    r -= TR_OUT;
    if (r < TR_G + TR_U) { const int up = r >= TR_G; const int q = up ? r - TR_G : r; const int ct = q >> 4, kt = q & 15;
        t.src = (up ? p.w_up : p.w_gate) + (size_t)l * DM * FF; t.ld = FF; t.c0 = ct * 256; t.k0 = kt * 64; t.ksc = p.norm_ffn + l * DM;
        t.dst = (bf16_t*)(ws + WS_WGU + l * SZ_WGU); t.ldd = DM; t.mode = up ? 2 : 1; t.roff = 0; return t; }
    r -= TR_G + TR_U;
    { const int ct = r / 44, kt = r - ct * 44;
        t.src = p.w_down + (size_t)l * FF * DM; t.ld = DM; t.c0 = ct * 256; t.k0 = kt * 64; t.ksc = nullptr; t.dst = (bf16_t*)(ws + WS_WD + l * SZ_WD); t.ldd = FF; t.mode = 0; t.roff = 0; return t; }
}
DI void tr_store(const TrItem& t, const float* sm, int tid) {
    const int k8 = (tid & 7) * 8;
#pragma unroll
    for (int q = 0; q < 4; ++q) { const int n2 = (tid >> 3) + 64 * q;
        u32x4 w; w.x = pk2(sm[(k8 + 0) * 257 + n2], sm[(k8 + 1) * 257 + n2]); w.y = pk2(sm[(k8 + 2) * 257 + n2], sm[(k8 + 3) * 257 + n2]);
        w.z = pk2(sm[(k8 + 4) * 257 + n2], sm[(k8 + 5) * 257 + n2]); w.w = pk2(sm[(k8 + 6) * 257 + n2], sm[(k8 + 7) * 257 + n2]);
        const int n = t.c0 + n2; int drow;
        if (t.mode == 0) { const int np = n + t.roff; drow = (np & ~255) + 128 * ((np >> 5) & 1) + 32 * ((np >> 6) & 3) + (np & 31); }
        else if (t.mode == 4) { const int np = n + t.roff; drow = (np & ~255) + 128 * ((np >> 3) & 1) + 32 * ((np >> 6) & 3) + 8 * ((np >> 4) & 3) + (np & 7); }
        else drow = 256 * (n >> 7) + 128 * ((n >> 2) & 1) + 32 * ((n >> 5) & 3) + (t.mode == 2 ? 16 : 0) + 4 * ((n >> 3) & 3) + (n & 3);
        *(u32x4*)(t.dst + (size_t)drow * t.ldd + t.k0 + k8) = w; }
}

DI void phase0(const Params& p, unsigned char* lds) {
    unsigned char* ws = p.ws;
    const int tid = opaque_tid();
    float* sm0 = (float*)lds; float* sm1 = sm0 + 64 * 257;
    const int G = gridDim.x, nn = tid & 255, kq = tid >> 8;
    for (int it = blockIdx.x; it < NL * TR_PER; it += 2 * G) {
        const bool two = it + G < NL * TR_PER;
        const TrItem a = tr_decode(p, it), b = tr_decode(p, two ? it + G : it);
        float va[32], vb[32];
#pragma unroll
        for (int i = 0; i < 32; ++i) va[i] = a.src[(size_t)(a.k0 + kq + 2 * i) * a.ld + a.c0 + nn];
        if (two) {
#pragma unroll
            for (int i = 0; i < 32; ++i) vb[i] = b.src[(size_t)(b.k0 + kq + 2 * i) * b.ld + b.c0 + nn]; }
        if (a.ksc) {
#pragma unroll
            for (int i = 0; i < 32; ++i) va[i] *= a.ksc[a.k0 + kq + 2 * i]; }
#pragma unroll
        for (int i = 0; i < 32; ++i) sm0[(kq + 2 * i) * 257 + nn] = va[i];
        if (two) {
            if (b.ksc) {
#pragma unroll
                for (int i = 0; i < 32; ++i) vb[i] *= b.ksc[b.k0 + kq + 2 * i]; }
#pragma unroll
            for (int i = 0; i < 32; ++i) sm1[(kq + 2 * i) * 257 + nn] = vb[i]; }
        __syncthreads();
        tr_store(a, sm0, tid);
        if (two) tr_store(b, sm1, tid);
        __syncthreads();
    }
    for (int g = blockIdx.x; g < NL * TR_GK; g += G) {
            const int l = g / TR_GK, r = g - l * TR_GK;
            const int j = 4 * r + (tid >> 7), k0 = (tid & 127) * 8;
            float wj[16];
#pragma unroll
            for (int q = 0; q < 16; ++q) wj[q] = p.a_w_gk[((size_t)l * 16 + q) * 256 + j];
            float o[8];
#pragma unroll
            for (int e = 0; e < 8; ++e) { const float* wr_ = p.w_in + ((size_t)l * DM + k0 + e) * NORIG + 1024; float s = 0.f;
#pragma unroll
                for (int q = 0; q < 16; ++q) s += wr_[q] * wj[q];
                o[e] = s * p.norm_mix[l * DM + k0 + e]; }
            u32x4 w; w.x = pk2(o[0], o[1]); w.y = pk2(o[2], o[3]); w.z = pk2(o[4], o[5]); w.w = pk2(o[6], o[7]);
            *(u32x4*)((bf16_t*)(ws + WS_W1 + l * SZ_W1) + (size_t)(1024 + 128 * ((j >> 5) & 1) + 32 * ((j >> 6) & 3) + (j & 31)) * DM + k0) = w;
    }
    float* ss = (float*)(ws + WS_SSP);
    bf16_t* hb = (bf16_t*)(ws + WS_HB);
    const int lane = tid & 63, gw = blockIdx.x * 8 + (tid >> 6), nw = gridDim.x * 8;
    for (int row = gw; row < T; row += nw) { float sq = 0.f;
#pragma unroll
        for (int i = 0; i < 4; ++i) { const size_t o = (size_t)row * DM + i * 256 + lane * 4; const f32x4 v = *(const f32x4*)(p.x + o);
            sq += v[0] * v[0] + v[1] * v[1] + v[2] * v[2] + v[3] * v[3]; u32x2 w; w.x = pk2(v[0], v[1]); w.y = pk2(v[2], v[3]); *(u32x2*)(hb + o) = w; }
#pragma unroll
        for (int s = 1; s < 64; s <<= 1) sq += __shfl_xor(sq, s);
        if (lane < 16) ss[(size_t)row * 16 + lane] = lane == 0 ? sq : 0.f; }
}

DI int p16(int k) { return 8 * ((k >> 2) & 1) + 4 * (k >> 3) + (k & 3); }

typedef short v4i16_t __attribute__((ext_vector_type(4)));
DI bf16x8 vtr8(const bf16_t* p) {
    const v4i16_t lo = __builtin_amdgcn_ds_read_tr16_b64_v4i16((LAS v4i16_t*)p), hi = __builtin_amdgcn_ds_read_tr16_b64_v4i16((LAS v4i16_t*)(p + 8 * 72));
    return __builtin_shufflevector(lo, hi, 0, 1, 2, 3, 4, 5, 6, 7);
}

DI void out_tile_store(bf16_t* OB  , const u32x2 (&w0)[4], const u32x2 (&w1)[4], bf16_t* dst  , int lane) {
    const int j = lane & 31, hi = lane >> 5;
#pragma unroll
    for (int q = 0; q < 4; ++q) { *(u32x2*)(OB + j * 72 + 8 * q + 4 * hi) = w0[q]; *(u32x2*)(OB + j * 72 + 32 + 8 * q + 4 * hi) = w1[q]; }
    __builtin_amdgcn_fence(__ATOMIC_RELEASE, "wavefront"); __builtin_amdgcn_wave_barrier(); __builtin_amdgcn_fence(__ATOMIC_ACQUIRE, "wavefront");
    const int r = lane >> 3, c8 = lane & 7;
#pragma unroll
    for (int it = 0; it < 4; ++it) { const u32x4 v = *(const u32x4*)(OB + (8 * it + r) * 72 + 8 * c8); *(u32x4*)(dst + (size_t)(8 * it + r) * 512 + 8 * c8) = v; }
}

DI void mixer_B(int job, const bf16_t* P1, const float* __restrict__ rel_tab, bf16_t* Yb, unsigned char* lds) {
    const int tid = opaque_tid(), lane = tid & 63, w = __builtin_amdgcn_readfirstlane(tid >> 6), j = lane & 31, hi = lane >> 5;
    const int cg4 = job & 7, h = (job >> 3) & 7, b = job >> 6;
    const int c = cg4 * 4 + (w >> 1);
    const int qt = c * 64 + (w & 1) * 32 + j;
    const size_t qrow = (size_t)b * SEQ + qt;
    bf16_t* Ks = (bf16_t*)lds;
    bf16_t* Vs = Ks + 2 * 64 * 72;
    float* tab = (float*)(Vs + 2 * 64 * 72);
    if (tid < 257) tab[tid] = rel_tab[h * 257 + tid] * 1.4426950408889634f;
    bf16x8 qf[4];
#pragma unroll
    for (int kk = 0; kk < 4; ++kk) qf[kk] = *(const bf16x8*)(P1 + qrow * LD1 + B_Q + h * 64 + kk * 16 + hi * 8);
    f32x16 O0, O1;
#pragma unroll
    for (int r = 0; r < 16; ++r) { O0[r] = 0.f; O1[r] = 0.f; }
    float m_run = -1e30f, l_run = 0.f;
    const int kc_lo = cg4 * 4 - 8 < 0 ? 0 : cg4 * 4 - 8, kc_hi = cg4 * 4 + 3;
    const int skey = tid >> 3, sdc = tid & 7;
    const int voff = (4 * hi + ((lane & 15) >> 2)) * 72 + 16 * ((lane >> 4) & 1) + 4 * (lane & 3);
    u32x4 kreg, vreg, kreg1, vreg1;
    { const size_t gr = ((size_t)b * SEQ + kc_lo * 64 + skey) * LD1 + h * 64 + sdc * 8; kreg = *(const u32x4*)(P1 + gr + B_K); vreg = *(const u32x4*)(P1 + gr + B_V);
      kreg1 = *(const u32x4*)(P1 + gr + (size_t)64 * LD1 + B_K); vreg1 = *(const u32x4*)(P1 + gr + (size_t)64 * LD1 + B_V); }
    for (int kc0 = kc_lo; kc0 <= kc_hi; kc0 += 2) {
#pragma unroll
      for (int sub = 0; sub < 2; ++sub) {
        const int kc = kc0 + sub, buf = sub;
        *(u32x4*)(Ks + (buf * 64 + skey) * 72 + sdc * 8) = sub ? kreg1 : kreg;
        *(u32x4*)(Vs + (buf * 64 + skey) * 72 + sdc * 8) = sub ? vreg1 : vreg;
        if (kc + 2 <= kc_hi) { const size_t gr = ((size_t)b * SEQ + (kc + 2) * 64 + skey) * LD1 + h * 64 + sdc * 8;
            if (sub) { kreg1 = *(const u32x4*)(P1 + gr + B_K); vreg1 = *(const u32x4*)(P1 + gr + B_V); } else { kreg = *(const u32x4*)(P1 + gr + B_K); vreg = *(const u32x4*)(P1 + gr + B_V); } }
        __syncthreads();
        if (kc >= c - 8 && kc <= c) {
            f32x16 s0, s1;
#pragma unroll
            for (int r = 0; r < 16; ++r) { s0[r] = 0.f; s1[r] = 0.f; }
#pragma unroll
            for (int kk = 0; kk < 4; ++kk) {
                const bf16x8 a0 = *(const bf16x8*)(Ks + (buf * 64 + j) * 72 + kk * 16 + hi * 8), a1 = *(const bf16x8*)(Ks + (buf * 64 + 32 + j) * 72 + kk * 16 + hi * 8);
                s0 = MFMA32(a0, qf[kk], s0); s1 = MFMA32(a1, qf[kk], s1); }
            const int relbase = qt - kc * 64 + 128;
            float mt = -1e30f;
            if (kc * 64 + 63 + 128 <= c * 64 + (w & 1) * 32) {
                const float bc = tab[256];
#pragma unroll
                for (int r = 0; r < 16; ++r) { s0[r] = s0[r] * 0.18033688011112042f + bc; s1[r] = s1[r] * 0.18033688011112042f + bc; mt = fmaxf(mt, fmaxf(s0[r], s1[r])); }
            } else {
#pragma unroll
            for (int r = 0; r < 16; ++r) { const int k0 = crow(r, hi);
                int i0 = relbase - k0; i0 = i0 < 0 ? 0 : (i0 > 256 ? 256 : i0);
                int i1 = relbase - 32 - k0; i1 = i1 < 0 ? 0 : (i1 > 256 ? 256 : i1);
                s0[r] = s0[r] * 0.18033688011112042f + tab[i0]; s1[r] = s1[r] * 0.18033688011112042f + tab[i1];
                mt = fmaxf(mt, fmaxf(s0[r], s1[r])); }
            }
            mt = fmaxf(mt, __shfl_xor(mt, 32));
            if (__any(mt > m_run + 8.f)) {
                const float mn = fmaxf(m_run, mt), alpha = __builtin_amdgcn_exp2f(m_run - mn); m_run = mn; l_run *= alpha;
#pragma unroll
                for (int r = 0; r < 16; ++r) { O0[r] *= alpha; O1[r] *= alpha; } }
            float ps = 0.f;
#pragma unroll
            for (int r = 0; r < 16; ++r) { s0[r] = __builtin_amdgcn_exp2f(s0[r] - m_run); s1[r] = __builtin_amdgcn_exp2f(s1[r] - m_run); ps += s0[r] + s1[r]; }
            ps += __shfl_xor(ps, 32);
            l_run += ps;
#pragma unroll
            for (int s = 0; s < 2; ++s) {
                u32x4 pw0, pw1;
                pw0.x = pk2(s0[8 * s + 0], s0[8 * s + 1]); pw0.y = pk2(s0[8 * s + 2], s0[8 * s + 3]); pw0.z = pk2(s0[8 * s + 4], s0[8 * s + 5]); pw0.w = pk2(s0[8 * s + 6], s0[8 * s + 7]);
                pw1.x = pk2(s1[8 * s + 0], s1[8 * s + 1]); pw1.y = pk2(s1[8 * s + 2], s1[8 * s + 3]); pw1.z = pk2(s1[8 * s + 4], s1[8 * s + 5]); pw1.w = pk2(s1[8 * s + 6], s1[8 * s + 7]);
                const bf16x8 pb0 = __builtin_bit_cast(bf16x8, pw0), pb1 = __builtin_bit_cast(bf16x8, pw1);
                const bf16x8 v00 = vtr8(Vs + (buf * 64 + s * 16) * 72 + voff), v01 = vtr8(Vs + (buf * 64 + s * 16) * 72 + 32 + voff);
                const bf16x8 v10 = vtr8(Vs + (buf * 64 + 32 + s * 16) * 72 + voff), v11 = vtr8(Vs + (buf * 64 + 32 + s * 16) * 72 + 32 + voff);
                O0 = MFMA32(v00, pb0, O0); O1 = MFMA32(v01, pb0, O1);
                O0 = MFMA32(v10, pb1, O0); O1 = MFMA32(v11, pb1, O1); }
        }
      }
    }
    const float inv = 1.f / l_run;
    u32x2 w0[4], w1[4];
#pragma unroll
    for (int q = 0; q < 4; ++q) {
        w0[q].x = pk2(O0[4 * q] * inv, O0[4 * q + 1] * inv); w0[q].y = pk2(O0[4 * q + 2] * inv, O0[4 * q + 3] * inv);
        w1[q].x = pk2(O1[4 * q] * inv, O1[4 * q + 1] * inv); w1[q].y = pk2(O1[4 * q + 2] * inv, O1[4 * q + 3] * inv); }
    out_tile_store((bf16_t*)(lds + 40960) + w * 2304, w0, w1, Yb + (qrow - j) * 512 + h * 64, lane);
}

constexpr float DCUT = 2.3e-16f;
DI void mixer_D(int job, const bf16_t* P1, bf16_t* Yd, unsigned char* lds) {
    const int tid = opaque_tid(), lane = tid & 63, w = __builtin_amdgcn_readfirstlane(tid >> 6), j = lane & 31, hi = lane >> 5;
    const int qb = 7 - (job >> 6), bh = job & 63, b = bh >> 3, h = bh & 7;
    const int qt = qb * 256 + w * 32 + j;
    const size_t qrow = (size_t)b * SEQ + qt;
    bf16_t* Ks = (bf16_t*)lds;
    bf16_t* Vs = Ks + 2 * 64 * 72;
    volatile int* flags = (volatile int*)(Vs + 2 * 64 * 72);
    bf16x8 qf[4];
#pragma unroll
    for (int kk = 0; kk < 4; ++kk) qf[kk] = *(const bf16x8*)(P1 + qrow * LD1 + D_Q + h * 64 + kk * 16 + hi * 8);
    f32x16 O0, O1;
#pragma unroll
    for (int r = 0; r < 16; ++r) { O0[r] = 0.f; O1[r] = 0.f; }
    float carry = 1.f; bool alive = true;
    const int kt_hi = qb * 4 + 3, ktmax_w = qb * 4 + (w >> 1);
    const int skey = tid >> 3, sdc = tid & 7;
    const int voff = (4 * hi + ((lane & 15) >> 2)) * 72 + 16 * ((lane >> 4) & 1) + 4 * (lane & 3);
    u32x4 kreg, vreg, kreg1, vreg1;
    { const size_t gr = ((size_t)b * SEQ + kt_hi * 64 + skey) * LD1 + h * 64 + sdc * 8; kreg = *(const u32x4*)(P1 + gr + D_K); vreg = *(const u32x4*)(P1 + gr + D_V);
      kreg1 = *(const u32x4*)(P1 + gr - (size_t)64 * LD1 + D_K); vreg1 = *(const u32x4*)(P1 + gr - (size_t)64 * LD1 + D_V); }
    bool stop = false;
    for (int kt0 = kt_hi; kt0 >= 0 && !stop; kt0 -= 2) {
#pragma unroll
      for (int sub = 0; sub < 2; ++sub) {
        const int kt = kt0 - sub, buf = sub;
        *(u32x4*)(Ks + (buf * 64 + skey) * 72 + sdc * 8) = sub ? kreg1 : kreg;
        *(u32x4*)(Vs + (buf * 64 + skey) * 72 + sdc * 8) = sub ? vreg1 : vreg;
        if (lane == 0) flags[buf * 8 + w] = alive ? 1 : 0;
        if (kt >= 2) { const size_t gr = ((size_t)b * SEQ + (kt - 2) * 64 + skey) * LD1 + h * 64 + sdc * 8;
            if (sub) { kreg1 = *(const u32x4*)(P1 + gr + D_K); vreg1 = *(const u32x4*)(P1 + gr + D_V); } else { kreg = *(const u32x4*)(P1 + gr + D_K); vreg = *(const u32x4*)(P1 + gr + D_V); } }
        __syncthreads();
        int any = 0;
#pragma unroll
        for (int q = 0; q < 8; ++q) any |= flags[buf * 8 + q];
        if (!any) { stop = true; break; }
        if (alive && kt <= ktmax_w) {
            f32x16 s0, s1;
#pragma unroll
            for (int r = 0; r < 16; ++r) { s0[r] = 0.f; s1[r] = 0.f; }
#pragma unroll
            for (int kk = 0; kk < 4; ++kk) {
                const bf16x8 a0 = *(const bf16x8*)(Ks + (buf * 64 + j) * 72 + kk * 16 + hi * 8), a1 = *(const bf16x8*)(Ks + (buf * 64 + 32 + j) * 72 + kk * 16 + hi * 8);
                s0 = MFMA32(a0, qf[kk], s0); s1 = MFMA32(a1, qf[kk], s1); }
#pragma unroll
            for (int kb = 1; kb >= 0; --kb) {
                f32x16& sx = kb ? s1 : s0;
                const int kbase = kt * 64 + kb * 32;
                float sg[16], rr[16]; float gp[4];
#pragma unroll
                for (int q = 0; q < 4; ++q) { gp[q] = 1.f;
#pragma unroll
                    for (int m = 0; m < 4; ++m) { const int r = 4 * q + m;
                        const float e = __builtin_amdgcn_exp2f(fminf(sx[r] * 0.18033688011112042f, 115.4156f));
                        const float ri = __builtin_amdgcn_rcpf(1.f + e);
                        const bool masked = (kbase + crow(r, hi)) >= qt;
                        rr[r] = masked ? 1.f : ri; sg[r] = masked ? 0.f : e * ri; gp[q] *= rr[r]; } }
                float tq[4], tot[4];
#pragma unroll
                for (int q = 0; q < 4; ++q) { tq[q] = __shfl_xor(gp[q], 32); tot[q] = gp[q] * tq[q]; }
                float after = 1.f;
#pragma unroll
                for (int q = 3; q >= 0; --q) {
                    float run = carry * after * (hi == 0 ? tq[q] : 1.f);
#pragma unroll
                    for (int m = 3; m >= 0; --m) { const int r = 4 * q + m; sx[r] = sg[r] * run; run *= rr[r]; }
                    after *= tot[q]; }
                carry *= after;
            }
#pragma unroll
            for (int s = 0; s < 2; ++s) {
                u32x4 pw0, pw1;
                pw0.x = pk2(s0[8 * s + 0], s0[8 * s + 1]); pw0.y = pk2(s0[8 * s + 2], s0[8 * s + 3]); pw0.z = pk2(s0[8 * s + 4], s0[8 * s + 5]); pw0.w = pk2(s0[8 * s + 6], s0[8 * s + 7]);
                pw1.x = pk2(s1[8 * s + 0], s1[8 * s + 1]); pw1.y = pk2(s1[8 * s + 2], s1[8 * s + 3]); pw1.z = pk2(s1[8 * s + 4], s1[8 * s + 5]); pw1.w = pk2(s1[8 * s + 6], s1[8 * s + 7]);
                const bf16x8 pb0 = __builtin_bit_cast(bf16x8, pw0), pb1 = __builtin_bit_cast(bf16x8, pw1);
                const bf16x8 v00 = vtr8(Vs + (buf * 64 + s * 16) * 72 + voff), v01 = vtr8(Vs + (buf * 64 + s * 16) * 72 + 32 + voff);
                const bf16x8 v10 = vtr8(Vs + (buf * 64 + 32 + s * 16) * 72 + voff), v11 = vtr8(Vs + (buf * 64 + 32 + s * 16) * 72 + 32 + voff);
                O0 = MFMA32(v00, pb0, O0); O1 = MFMA32(v01, pb0, O1);
                O0 = MFMA32(v10, pb1, O0); O1 = MFMA32(v11, pb1, O1); }
            alive = __any(carry >= DCUT) != 0;
        }
      }
    }
    u32x2 w0[4], w1[4];
#pragma unroll
    for (int q = 0; q < 4; ++q) {
        w0[q].x = pk2(O0[4 * q], O0[4 * q + 1]); w0[q].y = pk2(O0[4 * q + 2], O0[4 * q + 3]);
        w1[q].x = pk2(O1[4 * q], O1[4 * q + 1]); w1[q].y = pk2(O1[4 * q + 2], O1[4 * q + 3]); }
    out_tile_store((bf16_t*)(lds + 40960) + w * 2304, w0, w1, Yd + (qrow - j) * 512 + h * 64, lane);
}

DI void mixer_A(int job, const bf16_t* P1, const float* __restrict__ bgk, const float* __restrict__ anorm, bf16_t* Ya, unsigned char* lds) {
    const int tid = opaque_tid(), lane = tid & 63, w = __builtin_amdgcn_readfirstlane(tid >> 6), j = lane & 31, hi = lane >> 5;
    const int b = job >> 2, h = job & 3;
    float* GK = (float*)lds;
    float* SEG = GK + 64 * 65;
    float* TOT = SEG + 512;
    bf16_t* Kb = (bf16_t*)(TOT + 64);
    bf16_t* Qs = Kb + 64 * 64;
    bf16_t* KDT = Qs + 64 * 72;
    bf16_t* VT = KDT + 64 * 72;
    float* Ys = (float*)(VT + 128 * 72);
    const int lt = tid >> 3, c8 = tid & 7;
    const int kx = tid & 63, seg = tid >> 6;
    f32x16 X;
#pragma unroll
    for (int r = 0; r < 16; ++r) X[r] = 0.f;
    float an[16];
#pragma unroll
    for (int e = 0; e < 16; ++e) an[e] = anorm[(tid & 7) * 16 + e];
    float bg[8];
#pragma unroll
    for (int e = 0; e < 8; ++e) bg[e] = bgk[h * 64 + c8 * 8 + e];
    u32x4 rq, rk, rg, rv0, rv1;
    { const bf16_t* rp = P1 + ((size_t)b * SEQ + lt) * LD1;
      rq = *(const u32x4*)(rp + A_Q + h * 64 + c8 * 8); rk = *(const u32x4*)(rp + A_K + h * 64 + c8 * 8); rg = *(const u32x4*)(rp + A_GK + h * 64 + c8 * 8);
      rv0 = *(const u32x4*)(rp + A_V + h * 128 + c8 * 8); rv1 = *(const u32x4*)(rp + A_V + h * 128 + 64 + c8 * 8); }
    for (int c = 0; c < 32; ++c) {
        *(u32x4*)(Qs + lt * 72 + c8 * 8) = rq; *(u32x4*)(Kb + lt * 64 + c8 * 8) = rk;
#pragma unroll
        for (int e = 0; e < 4; ++e) { const float x0 = bflo(rg[e]) + bg[2 * e], x1 = bfhi(rg[e]) + bg[2 * e + 1];
            GK[lt * 65 + c8 * 8 + 2 * e] = (fminf(x0, 0.f) - __logf(1.f + __expf(-fabsf(x0)))) * (1.f / 16.f);
            GK[lt * 65 + c8 * 8 + 2 * e + 1] = (fminf(x1, 0.f) - __logf(1.f + __expf(-fabsf(x1)))) * (1.f / 16.f); }
        *(u32x4*)(VT + lt * 136 + c8 * 8) = rv0; *(u32x4*)(VT + lt * 136 + 64 + c8 * 8) = rv1;
        const size_t grow_ = (size_t)b * SEQ + c * 64 + (tid >> 3);
        const u32x4 g0 = *(const u32x4*)(P1 + grow_ * LD1 + A_G + h * 128 + (tid & 7) * 16), g1 = *(const u32x4*)(P1 + grow_ * LD1 + A_G + h * 128 + (tid & 7) * 16 + 8);
        if (c < 31) { const bf16_t* rp = P1 + ((size_t)b * SEQ + (c + 1) * 64 + lt) * LD1;
            rq = *(const u32x4*)(rp + A_Q + h * 64 + c8 * 8); rk = *(const u32x4*)(rp + A_K + h * 64 + c8 * 8); rg = *(const u32x4*)(rp + A_GK + h * 64 + c8 * 8);
            rv0 = *(const u32x4*)(rp + A_V + h * 128 + c8 * 8); rv1 = *(const u32x4*)(rp + A_V + h * 128 + 64 + c8 * 8); }
        __syncthreads();
        float cum[8]; { float run = 0.f;
#pragma unroll
            for (int i = 0; i < 8; ++i) { run += GK[(8 * seg + i) * 65 + kx]; cum[i] = run; }
            SEG[seg * 64 + kx] = run; }
        __syncthreads();
        { float off = 0.f, total = 0.f;
#pragma unroll
          for (int s = 0; s < 8; ++s) { const float v = SEG[s * 64 + kx]; total += v; if (s < seg) off += v; }
          float kd[8];
#pragma unroll
          for (int i = 0; i < 8; ++i) kd[i] = bf2f(Kb[(8 * seg + i) * 64 + kx]) * __expf(total - (off + cum[i]));
          u32x4 wv; wv.x = pk2(kd[0], kd[1]); wv.y = pk2(kd[2], kd[3]); wv.z = pk2(kd[4], kd[5]); wv.w = pk2(kd[6], kd[7]);
          *(u32x4*)(KDT + kx * 72 + 8 * seg) = wv;
          if (seg == 0) TOT[kx] = __expf(total); }
        __syncthreads();
        { const int kb = w & 1, vb = w >> 1;
#pragma unroll
          for (int r = 0; r < 16; ++r) X[r] *= TOT[32 * kb + crow(r, hi)];
#pragma unroll
          for (int kk = 0; kk < 4; ++kk) { const bf16x8 a = *(const bf16x8*)(KDT + (32 * kb + j) * 72 + kk * 16 + hi * 8);
              const bf16_t* vp = VT + (16 * kk + 8 * hi + ((lane & 15) >> 2)) * 136 + 32 * vb + 16 * ((lane >> 4) & 1) + 4 * (lane & 3);
              const v4i16_t lo = __builtin_amdgcn_ds_read_tr16_b64_v4i16((LAS v4i16_t*)vp), hi4 = __builtin_amdgcn_ds_read_tr16_b64_v4i16((LAS v4i16_t*)(vp + 4 * 136));
              const bf16x8 bb = __builtin_shufflevector(lo, hi4, 0, 1, 2, 3, 4, 5, 6, 7);
              X = MFMA32(a, bb, X); }
          u32x4 xw0, xw1;
          xw0.x = pk2(X[0], X[1]); xw0.y = pk2(X[2], X[3]); xw0.z = pk2(X[4], X[5]); xw0.w = pk2(X[6], X[7]);
          xw1.x = pk2(X[8], X[9]); xw1.y = pk2(X[10], X[11]); xw1.z = pk2(X[12], X[13]); xw1.w = pk2(X[14], X[15]);
          const bf16x8 xs0 = __builtin_bit_cast(bf16x8, xw0), xs1 = __builtin_bit_cast(bf16x8, xw1);
#pragma unroll
          for (int tb = 0; tb < 2; ++tb) { f32x16 Y;
#pragma unroll
              for (int r = 0; r < 16; ++r) Y[r] = 0.f;
#pragma unroll
              for (int s2 = 0; s2 < 2; ++s2) { const bf16_t* qp = Qs + (32 * tb + j) * 72 + 32 * kb + 16 * s2 + 4 * hi;
                  const u32x2 qlo = *(const u32x2*)qp, qhi = *(const u32x2*)(qp + 8);
                  u32x4 qa; qa.x = qlo.x; qa.y = qlo.y; qa.z = qhi.x; qa.w = qhi.y;
                  Y = MFMA32(__builtin_bit_cast(bf16x8, qa), s2 ? xs1 : xs0, Y); }
#pragma unroll
              for (int r = 0; r < 16; ++r) Ys[(kb * 64 + 32 * tb + crow(r, hi)) * 132 + 32 * vb + j] = Y[r] * 0.125f; } }
        __syncthreads();
        { const int t = tid >> 3, vs = tid & 7; float y[16]; float sq = 0.f;
#pragma unroll
          for (int i = 0; i < 4; ++i) { const f32x4 v = *(const f32x4*)(Ys + t * 132 + vs * 16 + 4 * i) + *(const f32x4*)(Ys + (64 + t) * 132 + vs * 16 + 4 * i); y[4 * i] = v[0]; y[4 * i + 1] = v[1]; y[4 * i + 2] = v[2]; y[4 * i + 3] = v[3];
              sq += v[0] * v[0] + v[1] * v[1] + v[2] * v[2] + v[3] * v[3]; }
          sq += __shfl_xor(sq, 1); sq += __shfl_xor(sq, 2); sq += __shfl_xor(sq, 4);
          const float rs = rsqrtf(sq * (1.f / 128.f) + EPS);
          const size_t row = (size_t)b * SEQ + c * 64 + t;
          float o[16];
#pragma unroll
          for (int e = 0; e < 4; ++e) { const float ga = bflo(g0[e]), gb = bfhi(g0[e]), gc = bflo(g1[e]), gd = bfhi(g1[e]);
              o[2 * e] = y[2 * e] * rs * an[2 * e] * (ga * __builtin_amdgcn_rcpf(1.f + __expf(-ga)));
              o[2 * e + 1] = y[2 * e + 1] * rs * an[2 * e + 1] * (gb * __builtin_amdgcn_rcpf(1.f + __expf(-gb)));
              o[8 + 2 * e] = y[8 + 2 * e] * rs * an[8 + 2 * e] * (gc * __builtin_amdgcn_rcpf(1.f + __expf(-gc)));
              o[8 + 2 * e + 1] = y[8 + 2 * e + 1] * rs * an[8 + 2 * e + 1] * (gd * __builtin_amdgcn_rcpf(1.f + __expf(-gd))); }
          u32x4 w0, w1; w0.x = pk2(o[0], o[1]); w0.y = pk2(o[2], o[3]); w0.z = pk2(o[4], o[5]); w0.w = pk2(o[6], o[7]);
          w1.x = pk2(o[8], o[9]); w1.y = pk2(o[10], o[11]); w1.z = pk2(o[12], o[13]); w1.w = pk2(o[14], o[15]);
          *(u32x4*)(Ya + row * 512 + h * 128 + vs * 16) = w0; *(u32x4*)(Ya + row * 512 + h * 128 + vs * 16 + 8) = w1; }
    }
}

DI void mixer_C(int job, const bf16_t* P1, const float* __restrict__ conv_w, const float* __restrict__ conv_b, const float* __restrict__ w_a, const float* __restrict__ b_a,
                const float* __restrict__ w_x, const float* __restrict__ b_x, const float* __restrict__ lam, bf16_t* Yc, unsigned char* lds) {
    const int tid = opaque_tid(), lane = tid & 63, w = __builtin_amdgcn_readfirstlane(tid >> 6), j = lane & 31, hi = lane >> 5;
    const int b = job >> 3, g = job & 7;
    bf16_t* XC = (bf16_t*)lds;
    bf16_t* WA = XC + 64 * 72;
    bf16_t* WX = WA + 64 * 72;
    float* RI = (float*)(WX + 64 * 72);
    float* SEGA = RI + 2 * 64 * 65;
    float* SEGH = SEGA + 512;
    const int ch = tid & 63, seg = tid >> 6, cc = g * 64 + ch;
#pragma unroll
    for (int n = 0; n < 8; ++n) { const int idx = tid + 512 * n, i = idx >> 6, jj = idx & 63;
        WA[jj * 72 + i] = f2bf(w_a[(size_t)g * 4096 + idx]); WX[jj * 72 + i] = f2bf(w_x[(size_t)g * 4096 + idx]); }
    const float cw0 = conv_w[cc], cw1 = conv_w[512 + cc], cw2 = conv_w[1024 + cc], cw3 = conv_w[1536 + cc], cb = conv_b[cc];
    const float ba = b_a[cc], bxb = b_x[cc], spl = log1pf(expf(-lam[cc]));
    float hcar = 0.f;
    bf16_t* XIN = (bf16_t*)(SEGH + 512);
    bf16_t* GIN = XIN + 2 * 67 * 64;
    bf16_t* YOUT = GIN + 2 * 64 * 64;
    const int lt = tid >> 3, c8 = tid & 7;
    const bf16_t* xg = P1 + (size_t)b * SEQ * LD1 + C_X + g * 64 + c8 * 8;
    const bf16_t* gg = P1 + (size_t)b * SEQ * LD1 + C_G + g * 64 + c8 * 8;
    u32x4 rx, rh, rg;
    { const u32x4 x0 = *(const u32x4*)(xg + (size_t)lt * LD1), g0 = *(const u32x4*)(gg + (size_t)lt * LD1);
      *(u32x4*)(XIN + (3 + lt) * 64 + c8 * 8) = x0; *(u32x4*)(GIN + lt * 64 + c8 * 8) = g0;
      if (tid < 24) *(u32x4*)(XIN + (tid >> 3) * 64 + c8 * 8) = (u32x4){0u, 0u, 0u, 0u};
      rx = *(const u32x4*)(xg + (size_t)(64 + lt) * LD1); rg = *(const u32x4*)(gg + (size_t)(64 + lt) * LD1);
      rh = rx; if (tid < 24) rh = *(const u32x4*)(xg + (size_t)(61 + (tid >> 3)) * LD1); }
    __syncthreads();
    for (int tt = 0; tt < 32; ++tt) {
        const int t0 = tt * 64 + seg * 8, buf = tt & 1;
        float xl[11], gv[8];
#pragma unroll
        for (int m = 0; m < 11; ++m) xl[m] = bf2f(XIN[(buf * 67 + seg * 8 + m) * 64 + ch]);
#pragma unroll
        for (int i = 0; i < 8; ++i) gv[i] = bf2f(GIN[(buf * 64 + seg * 8 + i) * 64 + ch]);
        if (tt < 31) { *(u32x4*)(XIN + ((buf ^ 1) * 67 + 3 + lt) * 64 + c8 * 8) = rx; *(u32x4*)(GIN + ((buf ^ 1) * 64 + lt) * 64 + c8 * 8) = rg;
            if (tid < 24) *(u32x4*)(XIN + ((buf ^ 1) * 67 + (tid >> 3)) * 64 + c8 * 8) = rh; }
        if (tt < 30) { const size_t tn = (size_t)(tt + 2) * 64;
            rx = *(const u32x4*)(xg + (tn + lt) * LD1); rg = *(const u32x4*)(gg + (tn + lt) * LD1);
            if (tid < 24) rh = *(const u32x4*)(xg + (tn - 3 + (tid >> 3)) * LD1); }
        float xc[8];
#pragma unroll
        for (int i = 0; i < 8; ++i) { xc[i] = cb + cw0 * xl[i] + cw1 * xl[i + 1] + cw2 * xl[i + 2] + cw3 * xl[i + 3]; XC[(seg * 8 + i) * 72 + ch] = f2bf(xc[i]); }
        __syncthreads();
        if (tt > 0) *(u32x4*)(Yc + ((size_t)b * SEQ + (tt - 1) * 64 + lt) * 512 + g * 64 + c8 * 8) = *(const u32x4*)(YOUT + lt * 64 + c8 * 8);
        { const int mat = w & 1, jb = (w >> 1) & 1, tb = w >> 2; const bf16_t* WM = mat ? WX : WA; f32x16 R;
#pragma unroll
          for (int r = 0; r < 16; ++r) R[r] = 0.f;
#pragma unroll
          for (int kk = 0; kk < 4; ++kk) { const bf16x8 a = *(const bf16x8*)(XC + (32 * tb + j) * 72 + kk * 16 + hi * 8), bb = *(const bf16x8*)(WM + (32 * jb + j) * 72 + kk * 16 + hi * 8);
              R = MFMA32(a, bb, R); }
#pragma unroll
          for (int r = 0; r < 16; ++r) RI[mat * 4160 + (32 * tb + crow(r, hi)) * 65 + 32 * jb + j] = R[r]; }
        __syncthreads();
        float hl[8], pp[8]; { float hh = 0.f, pr = 1.f;
#pragma unroll
          for (int i = 0; i < 8; ++i) { const float rv = __builtin_amdgcn_rcpf(1.f + __expf(-(RI[(seg * 8 + i) * 65 + ch] + ba))), iv = __builtin_amdgcn_rcpf(1.f + __expf(-(RI[4160 + (seg * 8 + i) * 65 + ch] + bxb)));
              const float la = -8.f * rv * spl, a = __expf(la), x2 = 2.f * la;
              const float ser = -x2 * (1.f + x2 * 0.5f * (1.f + x2 * (1.f / 3.f) * (1.f + x2 * 0.25f * (1.f + x2 * 0.2f))));
              const float om = x2 > -0.1f ? ser : 1.f - a * a;
              const float mult = __builtin_amdgcn_sqrtf(fmaxf(om, 0.f)), bx = mult * (iv * xc[i]);
              hh = a * hh + bx; pr *= a; hl[i] = hh; pp[i] = pr; }
          SEGA[seg * 64 + ch] = pr; SEGH[seg * 64 + ch] = hh; }
        __syncthreads();
        float hc = hcar, hf = hcar;
#pragma unroll
        for (int s = 0; s < 8; ++s) { const float sa = SEGA[s * 64 + ch], sh = SEGH[s * 64 + ch]; hf = sa * hf + sh; if (s < seg) hc = sa * hc + sh; }
        hcar = hf;
#pragma unroll
        for (int i = 0; i < 8; ++i) { const float hv = hl[i] + pp[i] * hc; const float x = gv[i];
            const float u = 0.7978845608f * (x + 0.044715f * x * x * x); const float th = 1.f - 2.f * __builtin_amdgcn_rcpf(1.f + __expf(2.f * u));
            YOUT[(seg * 8 + i) * 64 + ch] = f2bf(0.5f * x * (1.f + th) * hv); }
    }
    __syncthreads();
    *(u32x4*)(Yc + ((size_t)b * SEQ + 31 * 64 + lt) * 512 + g * 64 + c8 * 8) = *(const u32x4*)(YOUT + lt * 64 + c8 * 8);
}

DI void rs_fill(LAS float* rst, const float* ssp, int grp) {
    const int tid = opaque_tid();
#pragma unroll
    for (int i = 0; i < 4; ++i) { const int r = tid + 512 * i; rst[r] = rsqrtf(ss_row(ssp, grp * 2048 + r) * (1.f / 1024.f) + EPS); }
    __syncthreads();
}

#ifndef RA
#define RA 1
#endif
#ifndef RC
#define RC 1
#endif
#ifndef RD
#define RD 1
#endif
#ifndef RB
#define RB 1
#endif
constexpr int NJ_A = 32 * RA, NJ_C = 64 * RC, NJ_D = 512 * RD, NJ_B = 512 * RB, NJOBS = NJ_A + NJ_C + NJ_D + NJ_B;

__global__ void __launch_bounds__(512, 2) fwd_megakernel(Params p) {
    extern __shared__ __attribute__((aligned(16))) unsigned char lds[];
    cg::grid_group grid = cg::this_grid();
    unsigned char* ws = p.ws;
    LAS unsigned char* llds = (LAS unsigned char*)lds;
    const int G = gridDim.x, tid = threadIdx.x;
    float* ss = (float*)(ws + WS_SSP);
    bf16_t* P1 = (bf16_t*)(ws + WS_P1); bf16_t* P2 = (bf16_t*)(ws + WS_P2); bf16_t* Y = (bf16_t*)(ws + WS_Y); bf16_t* HB = (bf16_t*)(ws + WS_HB);
    bf16_t* MX = P1;
    bf16_t* U = P1;
    unsigned* jobctr = (unsigned*)(ws + WS_CTL);
    if (tid < 2) ((volatile LAS unsigned*)(llds + XBST))[tid] = 0u;
    __syncthreads();
    const XcdBarrier xbar = xcd_barrier_post((unsigned*)(ws + WS_BAR), (volatile LAS unsigned*)(llds + XBST));
#define GSYNC() xcd_barrier(xbar)

#ifndef NO_P0
    for (int rep = 0; rep < REP_P0; ++rep) { if (rep) grid.sync(); phase0(p, lds); }
#endif
    if (gridDim.y == 7u) grid.sync();
    GSYNC();

    for (int l = 0; l < NL; ++l) {
#ifndef NO_G1
        for (int rep = 0; rep < REP_G1; ++rep) {
            if (rep) GSYNC();
            pg8::Gemm g{HB, (const bf16_t*)(ws + WS_W1 + l * SZ_W1), T, NIN, DM, 0, 0, 1}; pg8::StaticOrder S; S.init(T, NIN, G, (int)blockIdx.x, 1);
            rs_fill((LAS float*)(llds + RS_OFF), ss + (size_t)(2 * l) * T * 16, (int)blockIdx.x & 7);
            pg8::EpiProj E{P1, P2, (const LAS float*)(llds + RS_OFF)};
            pg8::gemm_phase<pg8::EpiProj, true>(llds, g, S, E);
        }
#endif
        GSYNC();
        for (int rep = 0; rep < REP_MIX; ++rep) {
            if (rep) GSYNC();
            for (;;) {
                __syncthreads();
                if (tid == 0) *(volatile int*)(lds + JOBSLOT) = (int)atomicAdd(jobctr + l + 4 * rep, 1u);
                __syncthreads();
                const int job = *(volatile int*)(lds + JOBSLOT);
                if (job >= NJOBS) break;
#ifndef NO_MA
                if (job < NJ_A) mixer_A(job % 32, P1, p.a_b_gk + l * 256, p.a_norm + l * 128, Y, lds);
                else
#endif
#ifndef NO_MC
                if (job < NJ_A + NJ_C) mixer_C((job - NJ_A) % 64, P1, p.c_conv_w + l * 2048, p.c_conv_b + l * 512, p.c_w_a + (size_t)l * 32768, p.c_b_a + l * 512, p.c_w_x + (size_t)l * 32768, p.c_b_x + l * 512, p.c_lambda + l * 512, Y + (size_t)2 * T * 512, lds);
                else
#endif
#ifndef NO_MD
                if (job < NJ_A + NJ_C + NJ_D) mixer_D((job - NJ_A - NJ_C) % 512, P1, Y + (size_t)3 * T * 512, lds);
                else
#endif
#ifndef NO_MB
                mixer_B((job - NJ_A - NJ_C - NJ_D) % 512, P1, p.b_rel + l * 8 * 257, Y + (size_t)1 * T * 512, lds);
#endif
                ;
            }
        }
        GSYNC();
#ifndef NO_G3
        for (int rep = 0; rep < REP_G3; ++rep) {
            if (rep) GSYNC();
            pg8::Gemm g{Y, (const bf16_t*)(ws + WS_WB + l * SZ_WB), T, DM, 512, (size_t)T * 512 * 2, (size_t)DM * 512 * 2, 4}; pg8::StaticOrder S; S.init(T, DM, G, (int)blockIdx.x, 4);
            pg8::EpiMerge E{P2, MX};
            pg8::gemm_phase<pg8::EpiMerge, true>(llds, g, S, E);
        }
#endif
        GSYNC();
#ifndef NO_G4
        {
            pg8::Gemm g{MX, (const bf16_t*)(ws + WS_WO + l * SZ_WO), T, DM, DM, 0, 0, 1}; pg8::StaticOrder S; S.init(T, DM, G, (int)blockIdx.x, 1);
            pg8::EpiResid E{l == 0 ? p.x : nullptr, (const bf16_t*)p.out  , nullptr, Y  , HB, ss + (size_t)(2 * l + 1) * T * 16};
            pg8::gemm_phase<pg8::EpiResid, true>(llds, g, S, E);
        }
#endif
        GSYNC();
#ifdef XSYNC
        for (int q = 0; q < XSYNC; ++q) GSYNC();
#endif
#ifndef NO_G5
        for (int rep = 0; rep < REP_G5; ++rep) {
            if (rep) GSYNC();
            pg8::Gemm g{HB, (const bf16_t*)(ws + WS_WGU + l * SZ_WGU), T, NGU, DM, 0, 0, 1}; pg8::StaticOrder S; S.init(T, NGU, G, (int)blockIdx.x, 1);
            rs_fill((LAS float*)(llds + RS_OFF), ss + (size_t)(2 * l + 1) * T * 16, (int)blockIdx.x & 7);
            pg8::EpiFfn E{U, (const LAS float*)(llds + RS_OFF)};
            pg8::gemm_phase<pg8::EpiFfn, true>(llds, g, S, E);
        }
#endif
        GSYNC();
#ifndef NO_G6
        {
            pg8::Gemm g{U, (const bf16_t*)(ws + WS_WD + l * SZ_WD), T, DM, FF, 0, 0, 1}; pg8::StaticOrder S; S.init(T, DM, G, (int)blockIdx.x, 1);
            pg8::EpiResid E{nullptr, Y, l == NL - 1 ? p.out : nullptr, (bf16_t*)p.out, HB, ss + (size_t)(2 * l + 2) * T * 16};
            pg8::gemm_phase<pg8::EpiResid, true>(llds, g, S, E);
        }
#endif
        GSYNC();
    }
    {
        const int lane = tid & 63, gw = blockIdx.x * 8 + (tid >> 6), nw = G * 8; const float* ssf = ss + (size_t)8 * T * 16;
        for (int row = gw; row < T; row += nw) { const float rs = rsqrtf(ss_row(ssf, row) * (1.f / 1024.f) + EPS);
#pragma unroll
            for (int i = 0; i < 4; ++i) { const size_t o = (size_t)row * DM + i * 256 + lane * 4; f32x4 v = *(const f32x4*)(p.out + o); const f32x4 gn = *(const f32x4*)(p.norm_final + i * 256 + lane * 4);
                v[0] *= rs * gn[0]; v[1] *= rs * gn[1]; v[2] *= rs * gn[2]; v[3] *= rs * gn[3]; *(f32x4*)(p.out + o) = v; } }
    }
}

extern "C" void kernel_launch(void* const* d_in, const int* in_sizes, int n_in, void* d_out, int out_size, void* d_ws, size_t ws_size, hipStream_t stream) {
    static int grid_blocks = 0;
    if (grid_blocks == 0) {
        if (n_in != 21 || out_size != T * DM || ws_size < WS_END) { fprintf(stderr, "kernel_launch: unexpected shapes (n_in %d out %d ws %zu need %zu)\n", n_in, out_size, ws_size, (size_t)WS_END); grid_blocks = -1; return; }
        int dev = 0, cus = 0, per_cu = 0;
        hipGetDevice(&dev);
        hipDeviceGetAttribute(&cus, hipDeviceAttributeMultiprocessorCount, dev);
        if (hipFuncSetAttribute((const void*)fwd_megakernel, hipFuncAttributeMaxDynamicSharedMemorySize, LDS_BYTES) != hipSuccess) { fprintf(stderr, "kernel_launch: hipFuncSetAttribute failed\n"); grid_blocks = -1; return; }
        if (hipOccupancyMaxActiveBlocksPerMultiprocessor(&per_cu, (const void*)fwd_megakernel, 512, LDS_BYTES) != hipSuccess || per_cu < 1) { fprintf(stderr, "kernel_launch: occupancy query failed (%d)\n", per_cu); per_cu = 1; }
        (void)hipGetLastError();
        grid_blocks = cus * per_cu;
    }
    if (grid_blocks < 0) return;
    Params p{};
    p.x = (const float*)d_in[0]; p.norm_mix = (const float*)d_in[1]; p.w_in = (const float*)d_in[2]; p.a_w_gk = (const float*)d_in[3]; p.a_b_gk = (const float*)d_in[4]; p.a_norm = (const float*)d_in[5];
    p.b_rel = (const float*)d_in[6]; p.c_conv_w = (const float*)d_in[7]; p.c_conv_b = (const float*)d_in[8]; p.c_w_a = (const float*)d_in[9]; p.c_b_a = (const float*)d_in[10]; p.c_w_x = (const float*)d_in[11];
    p.c_b_x = (const float*)d_in[12]; p.c_lambda = (const float*)d_in[13]; p.w_branch = (const float*)d_in[14]; p.w_out = (const float*)d_in[15]; p.norm_ffn = (const float*)d_in[16];
    p.w_gate = (const float*)d_in[17]; p.w_up = (const float*)d_in[18]; p.w_down = (const float*)d_in[19]; p.norm_final = (const float*)d_in[20];
    p.out = (float*)d_out; p.ws = (unsigned char*)d_ws;
    if (hipMemsetAsync((char*)d_ws + WS_CTL, 0, CTL_ZERO_BYTES, stream) != hipSuccess) { fprintf(stderr, "kernel_launch: memset failed\n"); return; }
    void* args[] = {&p};
    hipError_t e = hipLaunchCooperativeKernel((const void*)fwd_megakernel, dim3(grid_blocks), dim3(512), args, LDS_BYTES, stream);
    if (e != hipSuccess) fprintf(stderr, "cooperative launch failed: %s (grid %d)\n", hipGetErrorString(e), grid_blocks);
}
```

```cpp
#include <hip/hip_runtime.h>
#include <hip/hip_cooperative_groups.h>
#include <cstdio>
#include <cstdint>
namespace cg = cooperative_groups;

#define LAS __attribute__((address_space(3)))
typedef unsigned short bf16_t;
typedef short bf16x8 __attribute__((ext_vector_type(8)));
typedef float f32x4 __attribute__((ext_vector_type(4)));
typedef float f32x16 __attribute__((ext_vector_type(16)));
typedef unsigned u32x4 __attribute__((ext_vector_type(4)));
typedef unsigned u32x2 __attribute__((ext_vector_type(2)));
typedef float f32x2 __attribute__((ext_vector_type(2)));
typedef __bf16 bf16x2_t __attribute__((ext_vector_type(2)));
#define DI __device__ __forceinline__

constexpr int T = 16384, SEQ = 2048, DM = 1024, NL = 4;
constexpr int NORIG = 9744, NIN = 9984, LD1 = 5888, LD2 = 4096, FF = 2816, NGU = 5632;
constexpr int A_Q = 0, A_K = 256, A_V = 512, A_GK = 1024, A_G = 1280, B_Q = 1792, B_K = 2304, B_V = 2816, C_G = 3328, C_X = 3840, D_Q = 4352, D_K = 4864, D_V = 5376;
constexpr float EPS = 1e-6f;
constexpr size_t WS_CTL = 0, WS_SS = 4096, WS_W1 = 1u << 20;
constexpr size_t SZ_W1 = (size_t)NIN * DM * 2, SZ_WB = (size_t)4 * DM * 512 * 2, SZ_WO = (size_t)DM * DM * 2, SZ_WGU = (size_t)NGU * DM * 2, SZ_WD = (size_t)DM * FF * 2;
constexpr size_t WS_WB = WS_W1 + NL * SZ_W1, WS_WO = WS_WB + NL * SZ_WB, WS_WGU = WS_WO + NL * SZ_WO, WS_WD = WS_WGU + NL * SZ_WGU;
constexpr size_t WS_P1 = WS_WD + NL * SZ_WD, WS_P2 = WS_P1 + (size_t)T * LD1 * 2, WS_Y = WS_P2 + (size_t)T * LD2 * 2, WS_HB = WS_Y + (size_t)4 * T * 512 * 2, WS_SSP = WS_HB + (size_t)T * DM * 2, WS_END = WS_SSP + (size_t)9 * T * 64;
static_assert(WS_END <= 638582784ull, "workspace");
constexpr int LDS_BYTES = 147456, JOBSLOT = 140000, XBST = 140016, RS_OFF = 131072;
constexpr size_t WS_BAR = 4096, CTL_ZERO_BYTES = 32768;
#ifndef REP_MIX
#define REP_MIX 1
#endif
#ifndef REP_G1
#define REP_G1 1
#endif
#ifndef REP_G3
#define REP_G3 1
#endif
#ifndef REP_G5
#define REP_G5 1
#endif
#ifndef REP_P0
#define REP_P0 1
#endif

DI int opaque_tid() { int t = threadIdx.x; asm volatile("" : "+v"(t)); return t; }
DI unsigned pk2(float lo, float hi) { f32x2 v = {lo, hi}; bf16x2_t b = __builtin_convertvector(v, bf16x2_t); return __builtin_bit_cast(unsigned, b); }
DI float bflo(unsigned w) { return __uint_as_float(w << 16); }
DI float bfhi(unsigned w) { return __uint_as_float(w & 0xffff0000u); }
DI float bf2f(bf16_t v) { return __uint_as_float((unsigned)v << 16); }
DI bf16_t f2bf(float f) { return (bf16_t)(pk2(f, 0.f) & 0xffffu); }
DI float ss_row(const float* ssp, int row) { const f32x4* sp = (const f32x4*)(ssp + (size_t)row * 16); float s = 0.f;
#pragma unroll
    for (int q = 0; q < 4; ++q) { const f32x4 v = sp[q]; s += (v[0] + v[1]) + (v[2] + v[3]); } return s; }
DI int crow(int r, int hi) { return (r & 3) + 8 * (r >> 2) + 4 * hi; }
DI float sigmoidf_(float x) { return 1.f / (1.f + __expf(-x)); }
#define MFMA32(a, b, c) __builtin_amdgcn_mfma_f32_32x32x16_bf16((a), (b), (c), 0, 0, 0)


#define XB_TMO      128
#define XB_XCNT(j)  (256  + 64 * (j))
#define XB_XSUB(j)  (1280 + 64 * (j))
#define XB_XGEN(j)  (2304 + 64 * (j))
#define XB_TOP      3328
#define XB_TOPGEN   3392
#define XCD_BAR_WORDS 3456
#define XB_SPIN_CAP (1u << 22)
DI unsigned xb_ld(unsigned* p)              { return __hip_atomic_load(p, __ATOMIC_RELAXED, __HIP_MEMORY_SCOPE_AGENT); }
DI unsigned xb_add(unsigned* p, unsigned v) { return __hip_atomic_fetch_add(p, v, __ATOMIC_RELAXED, __HIP_MEMORY_SCOPE_AGENT); }
DI unsigned xb_xcc_id() { return (unsigned)__builtin_amdgcn_s_getreg((3 << 11) | 20) & 0xFu; }
#define XB_SPIN(cond, bar) do { unsigned _sp = 0; while (cond) { __builtin_amdgcn_s_sleep(1); \
    if ((++_sp & 255u) == 0u) { if (xb_ld(&(bar)[XB_TMO])) break; if (_sp > XB_SPIN_CAP) { atomicAdd(&(bar)[XB_TMO], 1u); break; } } } } while (0)
struct XcdBarrier { unsigned* bar; unsigned x; volatile LAS unsigned* st; };
DI XcdBarrier xcd_barrier_post(unsigned* bar, volatile LAS unsigned* st) {
    XcdBarrier b; b.bar = bar; b.x = xb_xcc_id(); b.st = st;
    if (threadIdx.x == 0) (void)xb_add(&bar[XB_XCNT(b.x)], 1u);
    return b;
}
DI void xcd_barrier_complete(unsigned* bar, unsigned x, unsigned& nloc, unsigned& nx) {
    const unsigned G = gridDim.x * gridDim.y * gridDim.z;
    unsigned sum, cnt, mine, sp = 0u;
    for (;;) {
        sum = 0u; cnt = 0u; mine = 0u;
#pragma unroll
        for (unsigned j = 0; j < 16; ++j) { const unsigned c = xb_ld(&bar[XB_XCNT(j)]); sum += c; cnt += (c > 0u) ? 1u : 0u; mine = (j == x) ? c : mine; }
        if (sum == G) break;
        __builtin_amdgcn_s_sleep(1);
        if ((++sp & 255u) == 0u) { if (xb_ld(&bar[XB_TMO])) break; if (sp > XB_SPIN_CAP) { atomicAdd(&bar[XB_TMO], 1u); break; } }
    }
    nloc = mine > 0u ? mine : 1u; nx = cnt > 0u ? cnt : 1u;
}
DI void xcd_barrier(const XcdBarrier& b) {
    asm volatile("s_waitcnt vmcnt(0)" ::: "memory");
    __syncthreads();
    if (threadIdx.x == 0) {
        unsigned* bar = b.bar;
        __builtin_amdgcn_s_waitcnt(0);
        unsigned nloc = b.st[0], nx = b.st[1];
        if (nloc == 0u) { xcd_barrier_complete(bar, b.x, nloc, nx); b.st[0] = nloc; b.st[1] = nx; }
        const unsigned old = xb_add(&bar[XB_XSUB(b.x)], 1u);
        const unsigned gen = old / nloc;
        if (old + 1u == (gen + 1u) * nloc) {
            __builtin_amdgcn_fence(__ATOMIC_RELEASE, "agent");
            asm volatile("s_waitcnt vmcnt(0)" ::: "memory");
            const unsigned og = xb_add(&bar[XB_TOP], 1u);
            const unsigned tg = og / nx;
            if (og + 1u == (tg + 1u) * nx) xb_add(&bar[XB_TOPGEN], 1u);
            else XB_SPIN(xb_ld(&bar[XB_TOPGEN]) == tg, bar);
            __builtin_amdgcn_fence(__ATOMIC_ACQUIRE, "agent");
            xb_add(&bar[XB_XGEN(b.x)], 1u);
            asm volatile("s_waitcnt vmcnt(0)" ::: "memory");
        } else {
            XB_SPIN(xb_ld(&bar[XB_XGEN(b.x)]) == gen, bar);
            __builtin_amdgcn_fence(__ATOMIC_ACQUIRE, "agent");
            asm volatile("s_waitcnt vmcnt(0)" ::: "memory");
        }
    }
    __syncthreads();
}

namespace pg8 {
constexpr int BM = 256, BK = 64, HALF = 128, HTB = HALF * BK * 2, NXCD = 8, WGM = 8;
DI int lds_byte(int r, int c) { const int st = (r >> 4) * 2 + (c >> 5), rr = r & 15, cc = c & 31, ob = rr * 64 + cc * 2; return st * 1024 + (ob ^ (((ob >> 9) & 1) << 5)); }
DI void stage_rc(int b, int& R, int& C) { const int st = b / 1024, sb = b % 1024, swz = sb ^ (((sb >> 9) & 1) << 5); R = (st >> 1) * 16 + swz / 64; C = (st & 1) * 32 + (swz % 64) / 2; }
DI int perm32(int rho) { const int n = rho >> 4, i = rho & 15; return 8 * (i >> 2) + 4 * n + (i & 3); }

struct Unit { int pm, pn, br; };
struct Gemm { const bf16_t* A; const bf16_t* Bt; int M, N, K; size_t brA, brB; int nbr; };

struct StaticOrder {
    int nN, nwg, G, c, sh;
    DI void init(int M, int N, int G_, int c_, int nbr_) { nN = N / BM; nwg = (M / BM) * nN; G = G_; c = c_; sh = nbr_ == 4 ? 2 : 0; }
    DI bool next(int i, Unit& u) const {
        const int ti = i >> sh; u.br = i & ((1 << sh) - 1);
        const int L = ti * G + c; if (L >= nwg) return false;
        int wgid = L; { const int q = nwg / NXCD, r = nwg % NXCD, xcd = wgid % NXCD, off = wgid / NXCD; wgid = (xcd < r ? xcd * (q + 1) : r * (q + 1) + (xcd - r) * q) + off; }
        const int nig = WGM * nN, gid = wgid / nig, rem = wgid - gid * nig;
        u.pm = gid * WGM + (rem & 7); u.pn = rem >> 3; return true;
    }
};

template <class Epi, bool ALIGN_EPI>
DI void gemm_phase(LAS unsigned char* lds, const Gemm g, const StaticOrder& S, const Epi& E) {
    const int tid = opaque_tid(), wid = __builtin_amdgcn_readfirstlane(tid >> 6), lane = tid & 63, wr = wid >> 2, wc = wid & 3, fr = lane & 15, fq = lane >> 4;
    const int K = g.K, nt = K / BK;
    unsigned voffA[2], voffB[2];
#pragma unroll
    for (int i = 0; i < 2; ++i) { int R, C; stage_rc(tid * 16 + i * 8192, R, C); const int Rb = Epi::PERM ? ((R & ~31) + perm32(R & 31)) : R;
        voffA[i] = (unsigned)(R * K + C) * 2u; voffB[i] = (unsigned)(Rb * K + C) * 2u; }
    const size_t kstep = (size_t)(BK * 2);
    const size_t hstep = (size_t)HALF * K * 2;
    const size_t tstep = 2 * hstep;
    const unsigned ldsw = (unsigned)wid * 1024u;
    const int aoff = lds_byte(wr * 64 + fr, fq * 8), boff = lds_byte(wc * 32 + fr, fq * 8);
#define PG8_SA(b, h) (((b) * 2 + (h)) * HTB)
#define PG8_SB(b, h) ((4 + (b) * 2 + (h)) * HTB)
#define PG8_STAGE(bufoff, gbase, voff) do { _Pragma("unroll") for (int _i = 0; _i < 2; ++_i) \
        __builtin_amdgcn_global_load_lds((const unsigned*)((const char*)(gbase) + (voff)[_i]), (LAS unsigned*)(lds + (bufoff) + ldsw + _i * 8192), 16, 0, 0); } while (0)
#define PG8_LDA(dst, b, h) do { _Pragma("unroll") for (int m = 0; m < 4; ++m) _Pragma("unroll") for (int k = 0; k < 2; ++k) dst[m][k] = *(const LAS bf16x8*)(lds + PG8_SA(b, h) + aoff + m * 2048 + k * 1024); } while (0)
#define PG8_LDB(dst, b, h) do { _Pragma("unroll") for (int n = 0; n < 2; ++n) _Pragma("unroll") for (int k = 0; k < 2; ++k) dst[n][k] = *(const LAS bf16x8*)(lds + PG8_SB(b, h) + boff + n * 2048 + k * 1024); } while (0)
#define PG8_MMA(ai, bj, At, Bt) do { __builtin_amdgcn_s_setprio(1); _Pragma("unroll") for (int m = 0; m < 4; ++m) _Pragma("unroll") for (int n = 0; n < 2; ++n) _Pragma("unroll") for (int k = 0; k < 2; ++k) \
        acc[ai][bj][m][n] = __builtin_amdgcn_mfma_f32_16x16x32_bf16(Bt[n][k], At[m][k], acc[ai][bj][m][n], 0, 0, 0); __builtin_amdgcn_s_setprio(0); } while (0)
#define PG8_WAIT_V(n) asm volatile("s_waitcnt vmcnt(" #n ")" ::: "memory")
#define PG8_WAIT_L(n) asm volatile("s_waitcnt lgkmcnt(" #n ")" ::: "memory")
#define PG8_BAR __builtin_amdgcn_s_barrier()
#define PG8_SCHED __builtin_amdgcn_sched_barrier(0)
#define PG8_ZERO() do { _Pragma("unroll") for (int a = 0; a < 2; ++a) _Pragma("unroll") for (int b = 0; b < 2; ++b) _Pragma("unroll") for (int m = 0; m < 4; ++m) _Pragma("unroll") for (int n = 0; n < 2; ++n) acc[a][b][m][n] = (f32x4){0.f, 0.f, 0.f, 0.f}; } while (0)
    Unit cur, nxt; int ui = 0;
    if (!S.next(0, cur)) return;
    f32x4 acc[2][2][4][2];
    if constexpr (Epi::INIT) E.init(acc, cur, wr, wc, fr, fq); else PG8_ZERO();
    bf16x8 At[4][2], B0[2][2], B1[2][2];
    const char* cA = (const char*)g.A + (size_t)cur.pm * tstep + (size_t)cur.br * g.brA; const char* cB = (const char*)g.Bt + (size_t)cur.pn * tstep + (size_t)cur.br * g.brB;
    PG8_STAGE(PG8_SB(0, 0), cB, voffB); PG8_STAGE(PG8_SB(0, 1), cB + hstep, voffB); PG8_STAGE(PG8_SA(0, 0), cA, voffA); PG8_STAGE(PG8_SA(0, 1), cA + hstep, voffA);
    if (wr == 1) PG8_BAR;
    PG8_WAIT_V(2); PG8_BAR;
    PG8_STAGE(PG8_SB(1, 0), cB + kstep, voffB); PG8_STAGE(PG8_SA(1, 0), cA + kstep, voffA); PG8_STAGE(PG8_SB(1, 1), cB + hstep + kstep, voffB);
    PG8_WAIT_V(6); PG8_BAR;
    for (;;) {
        const bool has_next = S.next(ui + 1, nxt);
        const char* nA = has_next ? (const char*)g.A + (size_t)nxt.pm * tstep + (size_t)nxt.br * g.brA : cA; const char* nB = has_next ? (const char*)g.Bt + (size_t)nxt.pn * tstep + (size_t)nxt.br * g.brB : cB;
        for (int t = 0; t < nt; t += 2) {
            const bool last = (t == nt - 2);
            const char* a1 = cA + (size_t)(t + 1) * kstep;
            const char* a2 = last ? nA : cA + (size_t)(t + 2) * kstep; const char* b2 = last ? nB : cB + (size_t)(t + 2) * kstep;
            const char* a3 = a2 + kstep; const char* b3 = b2 + kstep;
            PG8_LDB(B0, 0, 0); PG8_LDB(B1, 0, 1); PG8_SCHED; PG8_LDA(At, 0, 0); PG8_STAGE(PG8_SA(1, 1), a1 + hstep, voffA);
            PG8_WAIT_V(8); PG8_WAIT_L(0); PG8_BAR; PG8_MMA(0, 0, At, B0); PG8_MMA(0, 1, At, B1); PG8_BAR; PG8_SCHED;
            PG8_LDA(At, 0, 1); PG8_STAGE(PG8_SB(0, 0), b2, voffB); PG8_STAGE(PG8_SB(0, 1), b2 + hstep, voffB); PG8_STAGE(PG8_SA(0, 0), a2, voffA);
            PG8_WAIT_V(8); PG8_WAIT_L(0); PG8_BAR; PG8_MMA(1, 0, At, B0); PG8_MMA(1, 1, At, B1); PG8_BAR; PG8_SCHED;
            PG8_LDB(B0, 1, 0); PG8_LDB(B1, 1, 1); PG8_SCHED; PG8_LDA(At, 1, 0); PG8_STAGE(PG8_SA(0, 1), a2 + hstep, voffA);
            PG8_WAIT_V(8); PG8_WAIT_L(0); PG8_BAR; PG8_MMA(0, 0, At, B0); PG8_MMA(0, 1, At, B1); PG8_BAR; PG8_SCHED;
            PG8_LDA(At, 1, 1); PG8_STAGE(PG8_SB(1, 0), b3, voffB); PG8_STAGE(PG8_SB(1, 1), b3 + hstep, voffB); PG8_STAGE(PG8_SA(1, 0), a3, voffA);
            PG8_WAIT_V(8); PG8_WAIT_L(0); PG8_BAR; PG8_MMA(1, 0, At, B0); PG8_MMA(1, 1, At, B1); PG8_BAR; PG8_SCHED;
        }
        if constexpr (ALIGN_EPI) { if (wr == 0) PG8_BAR; }
        E(acc, cur, wr, wc, fr, fq);
        if (!has_next) break;
        if constexpr (Epi::INIT) E.init(acc, nxt, wr, wc, fr, fq); else if (!(Epi::MULTI && nxt.br != 0)) PG8_ZERO();
        cur = nxt; cA = nA; cB = nB; ++ui;
        if constexpr (ALIGN_EPI) { if (wr == 1) PG8_BAR; }
    }
    PG8_WAIT_V(0);
    if constexpr (!ALIGN_EPI) { if (wr == 0) PG8_BAR; }
    PG8_BAR;
#undef PG8_SA
#undef PG8_SB
#undef PG8_STAGE
#undef PG8_LDA
#undef PG8_LDB
#undef PG8_MMA
#undef PG8_WAIT_V
#undef PG8_WAIT_L
#undef PG8_BAR
#undef PG8_SCHED
#undef PG8_ZERO
}

struct EpiProj {
    static constexpr bool PERM = true, MULTI = false, INIT = false;
    bf16_t* P1; bf16_t* P2; const LAS float* rst;
    DI void operator()(f32x4 (&acc)[2][2][4][2], const Unit& u, int wr, int wc, int fr, int fq) const {
        const int row0 = u.pm * BM + wr * 64 + fr;
        bf16_t* base; int ldc, colt;
        if (u.pn < 23) { base = P1; ldc = LD1; colt = u.pn * BM; } else { base = P2; ldc = LD2; colt = (u.pn - 23) * BM; }
        const int col0 = colt + wc * 64 + 8 * fq;
#pragma unroll
        for (int ai = 0; ai < 2; ++ai)
#pragma unroll
            for (int m = 0; m < 4; ++m) { const int row = row0 + ai * HALF + m * 16; const float rs = rst[row & 2047];
                bf16_t* rowp = base + (size_t)row * ldc + col0;
                if (u.pn >= 23) {
                    u32x4 wq;
#pragma unroll
                    for (int bj = 0; bj < 2; ++bj) { const f32x4 v0 = acc[ai][bj][m][0] * rs, v1 = acc[ai][bj][m][1] * rs; unsigned q0 = 0u, q1 = 0u;
#pragma unroll
                        for (int e = 0; e < 4; ++e) {
                            const unsigned a = (unsigned)fmaxf(__builtin_amdgcn_rcpf(1.f + __expf(-v0[e])) * 255.f + 0.5f, 1.f), b = (unsigned)fmaxf(__builtin_amdgcn_rcpf(1.f + __expf(-v1[e])) * 255.f + 0.5f, 1.f);
                            q0 |= a << (8 * e); q1 |= b << (8 * e); }
                        if (bj == 0) { wq.x = q0; wq.y = q1; } else { wq.z = q0; wq.w = q1; } }
                    *(u32x4*)((unsigned char*)P2 + (size_t)row * LD2 + (u.pn - 23) * BM + wc * 64 + 16 * fq) = wq;
                } else {
#pragma unroll
                for (int bj = 0; bj < 2; ++bj) { const f32x4 v0 = acc[ai][bj][m][0] * rs, v1 = acc[ai][bj][m][1] * rs;
                    u32x4 w; w.x = pk2(v0[0], v0[1]); w.y = pk2(v0[2], v0[3]); w.z = pk2(v1[0], v1[1]); w.w = pk2(v1[2], v1[3]);
                    *(u32x4*)(rowp + bj * 32) = w; } } }
    }
};
struct EpiMerge {
    static constexpr bool PERM = true, MULTI = true, INIT = false;
    const bf16_t* P2; bf16_t* MX;
    DI void operator()(f32x4 (&acc)[2][2][4][2], const Unit& u, int wr, int wc, int fr, int fq) const {
        const int row0 = u.pm * BM + wr * 64 + fr, col0 = u.pn * BM + wc * 64 + 8 * fq, br = u.br;
#pragma unroll
        for (int ai = 0; ai < 2; ++ai)
#pragma unroll
            for (int m = 0; m < 4; ++m) { const int row = row0 + ai * HALF + m * 16;
                const unsigned char* gp = (const unsigned char*)P2 + (size_t)row * LD2 + br * 1024 + u.pn * BM + wc * 64 + 16 * fq;
                const u32x4 ga = *(const u32x4*)gp; u32x4 gb = ga; if (br < 3) gb = *(const u32x4*)(gp + 1024);
#pragma unroll
                for (int bj = 0; bj < 2; ++bj) { const int col = col0 + bj * 32;
                    float f[8];
#pragma unroll
                    for (int e = 0; e < 8; ++e) { const float a_ = (float)((ga[2 * bj + (e >> 2)] >> (8 * (e & 3))) & 0xffu);
                        f[e] = br < 3 ? a_ * __builtin_amdgcn_rcpf((float)((gb[2 * bj + (e >> 2)] >> (8 * (e & 3))) & 0xffu)) : a_ * (1.f / 255.f); }
                    f32x4 v0 = acc[ai][bj][m][0], v1 = acc[ai][bj][m][1];
                    v0[0] *= f[0]; v0[1] *= f[1]; v0[2] *= f[2]; v0[3] *= f[3]; v1[0] *= f[4]; v1[1] *= f[5]; v1[2] *= f[6]; v1[3] *= f[7];
                    acc[ai][bj][m][0] = v0; acc[ai][bj][m][1] = v1;
                    if (br == 3) { u32x4 w; w.x = pk2(v0[0], v0[1]); w.y = pk2(v0[2], v0[3]); w.z = pk2(v1[0], v1[1]); w.w = pk2(v1[2], v1[3]);
                        *(u32x4*)(MX + (size_t)row * DM + col) = w; } } }
    }
};
struct EpiResid {
    static constexpr bool PERM = true, MULTI = false, INIT = true;
    const float* rin32; const bf16_t* lin; float* hout32; bf16_t* lout; bf16_t* hb; float* ssn;
    DI void init(f32x4 (&acc)[2][2][4][2], const Unit& u, int wr, int wc, int fr, int fq) const {
        const int row0 = u.pm * BM + wr * 64 + fr, col0 = u.pn * BM + wc * 64 + 8 * fq;
#pragma unroll
        for (int ai = 0; ai < 2; ++ai)
#pragma unroll
            for (int m = 0; m < 4; ++m)
#pragma unroll
                for (int bj = 0; bj < 2; ++bj) { const size_t o = (size_t)(row0 + ai * HALF + m * 16) * DM + col0 + bj * 32;
                    if (rin32) { acc[ai][bj][m][0] = *(const f32x4*)(rin32 + o); acc[ai][bj][m][1] = *(const f32x4*)(rin32 + o + 4); }
                    else { const u32x4 hi = *(const u32x4*)(hb + o), lo = *(const u32x4*)(lin + o);
                        acc[ai][bj][m][0] = (f32x4){bflo(hi.x) + bflo(lo.x), bfhi(hi.x) + bfhi(lo.x), bflo(hi.y) + bflo(lo.y), bfhi(hi.y) + bfhi(lo.y)};
                        acc[ai][bj][m][1] = (f32x4){bflo(hi.z) + bflo(lo.z), bfhi(hi.z) + bfhi(lo.z), bflo(hi.w) + bflo(lo.w), bfhi(hi.w) + bfhi(lo.w)}; } }
    }
    DI void operator()(f32x4 (&acc)[2][2][4][2], const Unit& u, int wr, int wc, int fr, int fq) const {
        const int row0 = u.pm * BM + wr * 64 + fr, col0 = u.pn * BM + wc * 64 + 8 * fq;
#pragma unroll
        for (int ai = 0; ai < 2; ++ai)
#pragma unroll
            for (int m = 0; m < 4; ++m) { const int row = row0 + ai * HALF + m * 16; float sq = 0.f;
#pragma unroll
                for (int bj = 0; bj < 2; ++bj) { const size_t o = (size_t)row * DM + col0 + bj * 32;
                    const f32x4 v0 = acc[ai][bj][m][0], v1 = acc[ai][bj][m][1];
                    u32x4 w; w.x = pk2(v0[0], v0[1]); w.y = pk2(v0[2], v0[3]); w.z = pk2(v1[0], v1[1]); w.w = pk2(v1[2], v1[3]);
                    if (hout32) { *(f32x4*)(hout32 + o) = v0; *(f32x4*)(hout32 + o + 4) = v1; }
                    else { *(u32x4*)(hb + o) = w; u32x4 l; l.x = pk2(v0[0] - bflo(w.x), v0[1] - bfhi(w.x)); l.y = pk2(v0[2] - bflo(w.y), v0[3] - bfhi(w.y));
                        l.z = pk2(v1[0] - bflo(w.z), v1[1] - bfhi(w.z)); l.w = pk2(v1[2] - bflo(w.w), v1[3] - bfhi(w.w));
                        *(u32x4*)(lout + o) = l; }
                    sq += v0[0] * v0[0] + v0[1] * v0[1] + v0[2] * v0[2] + v0[3] * v0[3] + v1[0] * v1[0] + v1[1] * v1[1] + v1[2] * v1[2] + v1[3] * v1[3]; }
                sq += __shfl_xor(sq, 16); sq += __shfl_xor(sq, 32);
                if (fq == 0) ssn[(size_t)row * 16 + u.pn * 4 + wc] = sq; }
    }
};
struct EpiFfn {
    static constexpr bool PERM = false, MULTI = false, INIT = false;
    bf16_t* U; const LAS float* rst;
    DI void operator()(f32x4 (&acc)[2][2][4][2], const Unit& u, int wr, int wc, int fr, int fq) const {
        const int row0 = u.pm * BM + wr * 64 + fr, col = 128 * u.pn + 32 * wc + 8 * fq;
#pragma unroll
        for (int ai = 0; ai < 2; ++ai)
#pragma unroll
            for (int m = 0; m < 4; ++m) { const int row = row0 + ai * HALF + m * 16; const float rs = rst[row & 2047]; float o[8];
#pragma unroll
                for (int bj = 0; bj < 2; ++bj) { const f32x4 gg = acc[ai][bj][m][0] * rs, uu = acc[ai][bj][m][1] * rs;
#pragma unroll
                    for (int e = 0; e < 4; ++e) o[4 * bj + e] = gg[e] * __builtin_amdgcn_rcpf(1.f + __expf(-gg[e])) * uu[e]; }
                u32x4 w; w.x = pk2(o[0], o[1]); w.y = pk2(o[2], o[3]); w.z = pk2(o[4], o[5]); w.w = pk2(o[6], o[7]);
                *(u32x4*)(U + (size_t)row * FF + col) = w; }
    }
};
}

struct Params {
    const float* x; const float* norm_mix; const float* w_in; const float* a_w_gk; const float* a_b_gk; const float* a_norm; const float* b_rel; const float* c_conv_w; const float* c_conv_b;
    const float* c_w_a; const float* c_b_a; const float* c_w_x; const float* c_b_x; const float* c_lambda; const float* w_branch; const float* w_out; const float* norm_ffn;
    const float* w_gate; const float* w_up; const float* w_down; const float* norm_final; float* out; unsigned char* ws;
};

struct TrItem { const float* src; const float* ksc; bf16_t* dst; int ld, c0, k0, ldd, mode, roff; };
constexpr int TR_IN = 608, TR_BR = 128, TR_OUT = 64, TR_G = 176, TR_U = 176, TR_D = 176, TR_PER = TR_IN + TR_BR + TR_OUT + TR_G + TR_U + TR_D, TR_GK = 64;
DI TrItem tr_decode(const Params& p, int it) {
    unsigned char* ws = p.ws; TrItem t; const int l = it / TR_PER; int r = it - l * TR_PER;
    if (r < TR_IN) { const int ct = r >> 4, kt = r & 15;
        t.src = p.w_in + (size_t)l * DM * NORIG; t.ld = NORIG; t.c0 = ct < 4 ? ct * 256 : 1040 + (ct - 4) * 256; t.k0 = kt * 64; t.ksc = p.norm_mix + l * DM;
        t.dst = (bf16_t*)(ws + WS_W1 + l * SZ_W1); t.ldd = DM; t.mode = 0; t.roff = ct < 4 ? 0 : 240; return t; }
    r -= TR_IN;
    if (r < TR_BR) { const int br = r >> 5, q = r & 31, ct = q >> 3, kt = q & 7;
        t.src = p.w_branch + ((size_t)l * 4 + br) * 512 * DM; t.ld = DM; t.c0 = ct * 256; t.k0 = kt * 64; t.ksc = nullptr;
        t.dst = (bf16_t*)(ws + WS_WB + l * SZ_WB) + (size_t)br * DM * 512; t.ldd = 512; t.mode = 0; t.roff = 0; return t; }
    r -= TR_BR;
    if (r < TR_OUT) { const int ct = r >> 4, kt = r & 15;
        t.src = p.w_out + (size_t)l * DM * DM; t.ld = DM; t.c0 = ct * 256; t.k0 = kt * 64; t.ksc = nullptr; t.dst = (bf16_t*)(ws + WS_WO + l * SZ_WO); t.ldd = DM; t.mode = 0; t.roff = 0; return t; }
    r -= TR_OUT;
    if (r < TR_G + TR_U) { const int up = r >= TR_G; const int q = up ? r - TR_G : r; const int ct = q >> 4, kt = q & 15;
        t.src = (up ? p.w_up : p.w_gate) + (size_t)l * DM * FF; t.ld = FF; t.c0 = ct * 256; t.k0 = kt * 64; t.ksc = p.norm_ffn + l * DM;
        t.dst = (bf16_t*)(ws + WS_WGU + l * SZ_WGU); t.ldd = DM; t.mode = up ? 2 : 1; t.roff = 0; return t; }
    r -= TR_G + TR_U;
    { const int ct = r / 44, kt = r - ct * 44;
        t.src = p.w_down + (size_t)l * FF * DM; t.ld = DM; t.c0 = ct * 256; t.k0 = kt * 64; t.ksc = nullptr; t.dst = (bf16_t*)(ws + WS_WD + l * SZ_WD); t.ldd = FF; t.mode = 0; t.roff = 0; return t; }
}
DI void tr_store(const TrItem& t, const float* sm, int tid) {
    const int k8 = (tid & 7) * 8;
#pragma unroll
    for (int q = 0; q < 4; ++q) { const int n2 = (tid >> 3) + 64 * q;
        u32x4 w; w.x = pk2(sm[(k8 + 0) * 257 + n2], sm[(k8 + 1) * 257 + n2]); w.y = pk2(sm[(k8 + 2) * 257 + n2], sm[(k8 + 3) * 257 + n2]);
        w.z = pk2(sm[(k8 + 4) * 257 + n2], sm[(k8 + 5) * 257 + n2]); w.w = pk2(sm[(k8 + 6) * 257 + n2], sm[(k8 + 7) * 257 + n2]);
        const int n = t.c0 + n2; int drow;
        if (t.mode == 0) { const int np = n + t.roff; drow = (np & ~255) + 128 * ((np >> 5) & 1) + 32 * ((np >> 6) & 3) + (np & 31); }
        else if (t.mode == 4) { const int np = n + t.roff; drow = (np & ~255) + 128 * ((np >> 3) & 1) + 32 * ((np >> 6) & 3) + 8 * ((np >> 4) & 3) + (np & 7); }
        else drow = 256 * (n >> 7) + 128 * ((n >> 2) & 1) + 32 * ((n >> 5) & 3) + (t.mode == 2 ? 16 : 0) + 4 * ((n >> 3) & 3) + (n & 3);
        *(u32x4*)(t.dst + (size_t)drow * t.ldd + t.k0 + k8) = w; }
}

DI void phase0(const Params& p, unsigned char* lds) {
    unsigned char* ws = p.ws;
    const int tid = opaque_tid();
    float* sm0 = (float*)lds; float* sm1 = sm0 + 64 * 257;
    const int G = gridDim.x, nn = tid & 255, kq = tid >> 8;
    for (int it = blockIdx.x; it < NL * TR_PER; it += 2 * G) {
        const bool two = it + G < NL * TR_PER;
        const TrItem a = tr_decode(p, it), b = tr_decode(p, two ? it + G : it);
        float va[32], vb[32];
#pragma unroll
        for (int i = 0; i < 32; ++i) va[i] = a.src[(size_t)(a.k0 + kq + 2 * i) * a.ld + a.c0 + nn];
        if (two) {
#pragma unroll
            for (int i = 0; i < 32; ++i) vb[i] = b.src[(size_t)(b.k0 + kq + 2 * i) * b.ld + b.c0 + nn]; }
        if (a.ksc) {
#pragma unroll
            for (int i = 0; i < 32; ++i) va[i] *= a.ksc[a.k0 + kq + 2 * i]; }
#pragma unroll
        for (int i = 0; i < 32; ++i) sm0[(kq + 2 * i) * 257 + nn] = va[i];
        if (two) {
            if (b.ksc) {
#pragma unroll
                for (int i = 0; i < 32; ++i) vb[i] *= b.ksc[b.k0 + kq + 2 * i]; }
#pragma unroll
            for (int i = 0; i < 32; ++i) sm1[(kq + 2 * i) * 257 + nn] = vb[i]; }
        __syncthreads();
        tr_store(a, sm0, tid);
        if (two) tr_store(b, sm1, tid);
        __syncthreads();
    }
    for (int g = blockIdx.x; g < NL * TR_GK; g += G) {
            const int l = g / TR_GK, r = g - l * TR_GK;
            const int j = 4 * r + (tid >> 7), k0 = (tid & 127) * 8;
            float wj[16];
#pragma unroll
            for (int q = 0; q < 16; ++q) wj[q] = p.a_w_gk[((size_t)l * 16 + q) * 256 + j];
            float o[8];
#pragma unroll
            for (int e = 0; e < 8; ++e) { const float* wr_ = p.w_in + ((size_t)l * DM + k0 + e) * NORIG + 1024; float s = 0.f;
#pragma unroll
                for (int q = 0; q < 16; ++q) s += wr_[q] * wj[q];
                o[e] = s * p.norm_mix[l * DM + k0 + e]; }
            u32x4 w; w.x = pk2(o[0], o[1]); w.y = pk2(o[2], o[3]); w.z = pk2(o[4], o[5]); w.w = pk2(o[6], o[7]);
            *(u32x4*)((bf16_t*)(ws + WS_W1 + l * SZ_W1) + (size_t)(1024 + 128 * ((j >> 5) & 1) + 32 * ((j >> 6) & 3) + (j & 31)) * DM + k0) = w;
    }
    float* ss = (float*)(ws + WS_SSP);
    bf16_t* hb = (bf16_t*)(ws + WS_HB);
    const int lane = tid & 63, gw = blockIdx.x * 8 + (tid >> 6), nw = gridDim.x * 8;
    for (int row = gw; row < T; row += nw) { float sq = 0.f;
#pragma unroll
        for (int i = 0; i < 4; ++i) { const size_t o = (size_t)row * DM + i * 256 + lane * 4; const f32x4 v = *(const f32x4*)(p.x + o);
            sq += v[0] * v[0] + v[1] * v[1] + v[2] * v[2] + v[3] * v[3]; u32x2 w; w.x = pk2(v[0], v[1]); w.y = pk2(v[2], v[3]); *(u32x2*)(hb + o) = w; }
#pragma unroll
        for (int s = 1; s < 64; s <<= 1) sq += __shfl_xor(sq, s);
        if (lane < 16) ss[(size_t)row * 16 + lane] = lane == 0 ? sq : 0.f; }
}

DI int p16(int k) { return 8 * ((k >> 2) & 1) + 4 * (k >> 3) + (k & 3); }

typedef short v4i16_t __attribute__((ext_vector_type(4)));
DI bf16x8 vtr8(const bf16_t* p) {
    const v4i16_t lo = __builtin_amdgcn_ds_read_tr16_b64_v4i16((LAS v4i16_t*)p), hi = __builtin_amdgcn_ds_read_tr16_b64_v4i16((LAS v4i16_t*)(p + 8 * 72));
    return __builtin_shufflevector(lo, hi, 0, 1, 2, 3, 4, 5, 6, 7);
}

DI void mixer_B(int job, const bf16_t* P1, const float* __restrict__ rel_tab, bf16_t* Yb, unsigned char* lds) {
    const int tid = opaque_tid(), lane = tid & 63, w = __builtin_amdgcn_readfirstlane(tid >> 6), j = lane & 31, hi = lane >> 5;
    const int cg4 = job & 7, h = (job >> 3) & 7, b = job >> 6;
    const int c = cg4 * 4 + (w >> 1);
    const int qt = c * 64 + (w & 1) * 32 + j;
    const size_t qrow = (size_t)b * SEQ + qt;
    bf16_t* Ks = (bf16_t*)lds;
    bf16_t* Vs = Ks + 2 * 64 * 72;
    float* tab = (float*)(Vs + 2 * 64 * 72);
    if (tid < 257) tab[tid] = rel_tab[h * 257 + tid] * 1.4426950408889634f;
    bf16x8 qf[4];
#pragma unroll
    for (int kk = 0; kk < 4; ++kk) qf[kk] = *(const bf16x8*)(P1 + qrow * LD1 + B_Q + h * 64 + kk * 16 + hi * 8);
    f32x16 O0, O1;
#pragma unroll
    for (int r = 0; r < 16; ++r) { O0[r] = 0.f; O1[r] = 0.f; }
    float m_run = -1e30f, l_run = 0.f;
    const int kc_lo = cg4 * 4 - 8 < 0 ? 0 : cg4 * 4 - 8, kc_hi = cg4 * 4 + 3;
    const int skey = tid >> 3, sdc = tid & 7;
    const int voff = (4 * hi + ((lane & 15) >> 2)) * 72 + 16 * ((lane >> 4) & 1) + 4 * (lane & 3);
    u32x4 kreg, vreg, kreg1, vreg1;
    { const size_t gr = ((size_t)b * SEQ + kc_lo * 64 + skey) * LD1 + h * 64 + sdc * 8; kreg = *(const u32x4*)(P1 + gr + B_K); vreg = *(const u32x4*)(P1 + gr + B_V);
      kreg1 = *(const u32x4*)(P1 + gr + (size_t)64 * LD1 + B_K); vreg1 = *(const u32x4*)(P1 + gr + (size_t)64 * LD1 + B_V); }
    for (int kc0 = kc_lo; kc0 <= kc_hi; kc0 += 2) {
#pragma unroll
      for (int sub = 0; sub < 2; ++sub) {
        const int kc = kc0 + sub, buf = sub;
        *(u32x4*)(Ks + (buf * 64 + skey) * 72 + sdc * 8) = sub ? kreg1 : kreg;
        *(u32x4*)(Vs + (buf * 64 + skey) * 72 + sdc * 8) = sub ? vreg1 : vreg;
        if (kc + 2 <= kc_hi) { const size_t gr = ((size_t)b * SEQ + (kc + 2) * 64 + skey) * LD1 + h * 64 + sdc * 8;
            if (sub) { kreg1 = *(const u32x4*)(P1 + gr + B_K); vreg1 = *(const u32x4*)(P1 + gr + B_V); } else { kreg = *(const u32x4*)(P1 + gr + B_K); vreg = *(const u32x4*)(P1 + gr + B_V); } }
        __syncthreads();
        if (kc >= c - 8 && kc <= c) {
            f32x16 s0, s1;
#pragma unroll
            for (int r = 0; r < 16; ++r) { s0[r] = 0.f; s1[r] = 0.f; }
#pragma unroll
            for (int kk = 0; kk < 4; ++kk) {
                const bf16x8 a0 = *(const bf16x8*)(Ks + (buf * 64 + j) * 72 + kk * 16 + hi * 8), a1 = *(const bf16x8*)(Ks + (buf * 64 + 32 + j) * 72 + kk * 16 + hi * 8);
                s0 = MFMA32(a0, qf[kk], s0); s1 = MFMA32(a1, qf[kk], s1); }
            const int relbase = qt - kc * 64 + 128;
            float mt = -1e30f;
            if (kc * 64 + 63 + 128 <= c * 64 + (w & 1) * 32) {
                const float bc = tab[256];
#pragma unroll
                for (int r = 0; r < 16; ++r) { s0[r] = s0[r] * 0.18033688011112042f + bc; s1[r] = s1[r] * 0.18033688011112042f + bc; mt = fmaxf(mt, fmaxf(s0[r], s1[r])); }
            } else {
#pragma unroll
            for (int r = 0; r < 16; ++r) { const int k0 = crow(r, hi);
                int i0 = relbase - k0; i0 = i0 < 0 ? 0 : (i0 > 256 ? 256 : i0);
                int i1 = relbase - 32 - k0; i1 = i1 < 0 ? 0 : (i1 > 256 ? 256 : i1);
                s0[r] = s0[r] * 0.18033688011112042f + tab[i0]; s1[r] = s1[r] * 0.18033688011112042f + tab[i1];
                mt = fmaxf(mt, fmaxf(s0[r], s1[r])); }
            }
            mt = fmaxf(mt, __shfl_xor(mt, 32));
            if (__any(mt > m_run + 8.f)) {
                const float mn = fmaxf(m_run, mt), alpha = __builtin_amdgcn_exp2f(m_run - mn); m_run = mn; l_run *= alpha;
#pragma unroll
                for (int r = 0; r < 16; ++r) { O0[r] *= alpha; O1[r] *= alpha; } }
            float ps = 0.f;
#pragma unroll
            for (int r = 0; r < 16; ++r) { s0[r] = __builtin_amdgcn_exp2f(s0[r] - m_run); s1[r] = __builtin_amdgcn_exp2f(s1[r] - m_run); ps += s0[r] + s1[r]; }
            ps += __shfl_xor(ps, 32);
            l_run += ps;
#pragma unroll
            for (int s = 0; s < 2; ++s) {
                u32x4 pw0, pw1;
                pw0.x = pk2(s0[8 * s + 0], s0[8 * s + 1]); pw0.y = pk2(s0[8 * s + 2], s0[8 * s + 3]); pw0.z = pk2(s0[8 * s + 4], s0[8 * s + 5]); pw0.w = pk2(s0[8 * s + 6], s0[8 * s + 7]);
                pw1.x = pk2(s1[8 * s + 0], s1[8 * s + 1]); pw1.y = pk2(s1[8 * s + 2], s1[8 * s + 3]); pw1.z = pk2(s1[8 * s + 4], s1[8 * s + 5]); pw1.w = pk2(s1[8 * s + 6], s1[8 * s + 7]);
                const bf16x8 pb0 = __builtin_bit_cast(bf16x8, pw0), pb1 = __builtin_bit_cast(bf16x8, pw1);
                const bf16x8 v00 = vtr8(Vs + (buf * 64 + s * 16) * 72 + voff), v01 = vtr8(Vs + (buf * 64 + s * 16) * 72 + 32 + voff);
                const bf16x8 v10 = vtr8(Vs + (buf * 64 + 32 + s * 16) * 72 + voff), v11 = vtr8(Vs + (buf * 64 + 32 + s * 16) * 72 + 32 + voff);
                O0 = MFMA32(v00, pb0, O0); O1 = MFMA32(v01, pb0, O1);
                O0 = MFMA32(v10, pb1, O0); O1 = MFMA32(v11, pb1, O1); }
        }
      }
    }
    const float inv = 1.f / l_run;
#pragma unroll
    for (int q = 0; q < 4; ++q) {
        u32x2 w0, w1; w0.x = pk2(O0[4 * q] * inv, O0[4 * q + 1] * inv); w0.y = pk2(O0[4 * q + 2] * inv, O0[4 * q + 3] * inv);
        w1.x = pk2(O1[4 * q] * inv, O1[4 * q + 1] * inv); w1.y = pk2(O1[4 * q + 2] * inv, O1[4 * q + 3] * inv);
        *(u32x2*)(Yb + qrow * 512 + h * 64 + 8 * q + 4 * hi) = w0; *(u32x2*)(Yb + qrow * 512 + h * 64 + 32 + 8 * q + 4 * hi) = w1; }
}

constexpr float DCUT = 2.3e-16f;
DI void mixer_D(int job, const bf16_t* P1, bf16_t* Yd, unsigned char* lds) {
    const int tid = opaque_tid(), lane = tid & 63, w = __builtin_amdgcn_readfirstlane(tid >> 6), j = lane & 31, hi = lane >> 5;
    const int qb = 7 - (job >> 6), bh = job & 63, b = bh >> 3, h = bh & 7;
    const int qt = qb * 256 + w * 32 + j;
    const size_t qrow = (size_t)b * SEQ + qt;
    bf16_t* Ks = (bf16_t*)lds;
    bf16_t* Vs = Ks + 2 * 64 * 72;
    volatile int* flags = (volatile int*)(Vs + 2 * 64 * 72);
    bf16x8 qf[4];
#pragma unroll
    for (int kk = 0; kk < 4; ++kk) qf[kk] = *(const bf16x8*)(P1 + qrow * LD1 + D_Q + h * 64 + kk * 16 + hi * 8);
    f32x16 O0, O1;
#pragma unroll
    for (int r = 0; r < 16; ++r) { O0[r] = 0.f; O1[r] = 0.f; }
    float carry = 1.f; bool alive = true;
    const int kt_hi = qb * 4 + 3, ktmax_w = qb * 4 + (w >> 1);
    const int skey = tid >> 3, sdc = tid & 7;
    const int voff = (4 * hi + ((lane & 15) >> 2)) * 72 + 16 * ((lane >> 4) & 1) + 4 * (lane & 3);
    u32x4 kreg, vreg, kreg1, vreg1;
    { const size_t gr = ((size_t)b * SEQ + kt_hi * 64 + skey) * LD1 + h * 64 + sdc * 8; kreg = *(const u32x4*)(P1 + gr + D_K); vreg = *(const u32x4*)(P1 + gr + D_V);
      kreg1 = *(const u32x4*)(P1 + gr - (size_t)64 * LD1 + D_K); vreg1 = *(const u32x4*)(P1 + gr - (size_t)64 * LD1 + D_V); }
    bool stop = false;
    for (int kt0 = kt_hi; kt0 >= 0 && !stop; kt0 -= 2) {
#pragma unroll
      for (int sub = 0; sub < 2; ++sub) {
        const int kt = kt0 - sub, buf = sub;
        *(u32x4*)(Ks + (buf * 64 + skey) * 72 + sdc * 8) = sub ? kreg1 : kreg;
        *(u32x4*)(Vs + (buf * 64 + skey) * 72 + sdc * 8) = sub ? vreg1 : vreg;
        if (lane == 0) flags[buf * 8 + w] = alive ? 1 : 0;
        if (kt >= 2) { const size_t gr = ((size_t)b * SEQ + (kt - 2) * 64 + skey) * LD1 + h * 64 + sdc * 8;
            if (sub) { kreg1 = *(const u32x4*)(P1 + gr + D_K); vreg1 = *(const u32x4*)(P1 + gr + D_V); } else { kreg = *(const u32x4*)(P1 + gr + D_K); vreg = *(const u32x4*)(P1 + gr + D_V); } }
        __syncthreads();
        int any = 0;
#pragma unroll
        for (int q = 0; q < 8; ++q) any |= flags[buf * 8 + q];
        if (!any) { stop = true; break; }
        if (alive && kt <= ktmax_w) {
            f32x16 s0, s1;
#pragma unroll
            for (int r = 0; r < 16; ++r) { s0[r] = 0.f; s1[r] = 0.f; }
#pragma unroll
            for (int kk = 0; kk < 4; ++kk) {
                const bf16x8 a0 = *(const bf16x8*)(Ks + (buf * 64 + j) * 72 + kk * 16 + hi * 8), a1 = *(const bf16x8*)(Ks + (buf * 64 + 32 + j) * 72 + kk * 16 + hi * 8);
                s0 = MFMA32(a0, qf[kk], s0); s1 = MFMA32(a1, qf[kk], s1); }
#pragma unroll
            for (int kb = 1; kb >= 0; --kb) {
                f32x16& sx = kb ? s1 : s0;
                const int kbase = kt * 64 + kb * 32;
                float sg[16], rr[16]; float gp[4];
#pragma unroll
                for (int q = 0; q < 4; ++q) { gp[q] = 1.f;
#pragma unroll
                    for (int m = 0; m < 4; ++m) { const int r = 4 * q + m;
                        const float e = __builtin_amdgcn_exp2f(fminf(sx[r] * 0.18033688011112042f, 115.4156f));
                        const float ri = __builtin_amdgcn_rcpf(1.f + e);
                        const bool masked = (kbase + crow(r, hi)) >= qt;
                        rr[r] = masked ? 1.f : ri; sg[r] = masked ? 0.f : e * ri; gp[q] *= rr[r]; } }
                float tq[4], tot[4];
#pragma unroll
                for (int q = 0; q < 4; ++q) { tq[q] = __shfl_xor(gp[q], 32); tot[q] = gp[q] * tq[q]; }
                float after = 1.f;
#pragma unroll
                for (int q = 3; q >= 0; --q) {
                    float run = carry * after * (hi == 0 ? tq[q] : 1.f);
#pragma unroll
                    for (int m = 3; m >= 0; --m) { const int r = 4 * q + m; sx[r] = sg[r] * run; run *= rr[r]; }
                    after *= tot[q]; }
                carry *= after;
            }
#pragma unroll
            for (int s = 0; s < 2; ++s) {
                u32x4 pw0, pw1;
                pw0.x = pk2(s0[8 * s + 0], s0[8 * s + 1]); pw0.y = pk2(s0[8 * s + 2], s0[8 * s + 3]); pw0.z = pk2(s0[8 * s + 4], s0[8 * s + 5]); pw0.w = pk2(s0[8 * s + 6], s0[8 * s + 7]);
                pw1.x = pk2(s1[8 * s + 0], s1[8 * s + 1]); pw1.y = pk2(s1[8 * s + 2], s1[8 * s + 3]); pw1.z = pk2(s1[8 * s + 4], s1[8 * s + 5]); pw1.w = pk2(s1[8 * s + 6], s1[8 * s + 7]);
                const bf16x8 pb0 = __builtin_bit_cast(bf16x8, pw0), pb1 = __builtin_bit_cast(bf16x8, pw1);
                const bf16x8 v00 = vtr8(Vs + (buf * 64 + s * 16) * 72 + voff), v01 = vtr8(Vs + (buf * 64 + s * 16) * 72 + 32 + voff);
                const bf16x8 v10 = vtr8(Vs + (buf * 64 + 32 + s * 16) * 72 + voff), v11 = vtr8(Vs + (buf * 64 + 32 + s * 16) * 72 + 32 + voff);
                O0 = MFMA32(v00, pb0, O0); O1 = MFMA32(v01, pb0, O1);
                O0 = MFMA32(v10, pb1, O0); O1 = MFMA32(v11, pb1, O1); }
            alive = __any(carry >= DCUT) != 0;
        }
      }
    }
#pragma unroll
    for (int q = 0; q < 4; ++q) {
        u32x2 w0, w1; w0.x = pk2(O0[4 * q], O0[4 * q + 1]); w0.y = pk2(O0[4 * q + 2], O0[4 * q + 3]);
        w1.x = pk2(O1[4 * q], O1[4 * q + 1]); w1.y = pk2(O1[4 * q + 2], O1[4 * q + 3]);
        *(u32x2*)(Yd + qrow * 512 + h * 64 + 8 * q + 4 * hi) = w0; *(u32x2*)(Yd + qrow * 512 + h * 64 + 32 + 8 * q + 4 * hi) = w1; }
}

DI void mixer_A(int job, const bf16_t* P1, const float* __restrict__ bgk, const float* __restrict__ anorm, bf16_t* Ya, unsigned char* lds) {
    const int tid = opaque_tid(), lane = tid & 63, w = __builtin_amdgcn_readfirstlane(tid >> 6), j = lane & 31, hi = lane >> 5;
    const int b = job >> 2, h = job & 3;
    float* GK = (float*)lds;
    float* SEG = GK + 64 * 65;
    float* TOT = SEG + 512;
    bf16_t* Kb = (bf16_t*)(TOT + 64);
    bf16_t* Qs = Kb + 64 * 64;
    bf16_t* KDT = Qs + 64 * 72;
    bf16_t* VT = KDT + 64 * 72;
    float* Ys = (float*)(VT + 128 * 72);
    const int lt = tid >> 3, c8 = tid & 7;
    const int kx = tid & 63, seg = tid >> 6;
    f32x16 X;
#pragma unroll
    for (int r = 0; r < 16; ++r) X[r] = 0.f;
    float an[16];
#pragma unroll
    for (int e = 0; e < 16; ++e) an[e] = anorm[(tid & 7) * 16 + e];
    float bg[8];
#pragma unroll
    for (int e = 0; e < 8; ++e) bg[e] = bgk[h * 64 + c8 * 8 + e];
    u32x4 rq, rk, rg, rv0, rv1;
    { const bf16_t* rp = P1 + ((size_t)b * SEQ + lt) * LD1;
      rq = *(const u32x4*)(rp + A_Q + h * 64 + c8 * 8); rk = *(const u32x4*)(rp + A_K + h * 64 + c8 * 8); rg = *(const u32x4*)(rp + A_GK + h * 64 + c8 * 8);
      rv0 = *(const u32x4*)(rp + A_V + h * 128 + c8 * 8); rv1 = *(const u32x4*)(rp + A_V + h * 128 + 64 + c8 * 8); }
    for (int c = 0; c < 32; ++c) {
        *(u32x4*)(Qs + lt * 72 + c8 * 8) = rq; *(u32x4*)(Kb + lt * 64 + c8 * 8) = rk;
#pragma unroll
        for (int e = 0; e < 4; ++e) { const float x0 = bflo(rg[e]) + bg[2 * e], x1 = bfhi(rg[e]) + bg[2 * e + 1];
            GK[lt * 65 + c8 * 8 + 2 * e] = (fminf(x0, 0.f) - __logf(1.f + __expf(-fabsf(x0)))) * (1.f / 16.f);
            GK[lt * 65 + c8 * 8 + 2 * e + 1] = (fminf(x1, 0.f) - __logf(1.f + __expf(-fabsf(x1)))) * (1.f / 16.f); }
        *(u32x4*)(VT + lt * 136 + c8 * 8) = rv0; *(u32x4*)(VT + lt * 136 + 64 + c8 * 8) = rv1;
        const size_t grow_ = (size_t)b * SEQ + c * 64 + (tid >> 3);
        const u32x4 g0 = *(const u32x4*)(P1 + grow_ * LD1 + A_G + h * 128 + (tid & 7) * 16), g1 = *(const u32x4*)(P1 + grow_ * LD1 + A_G + h * 128 + (tid & 7) * 16 + 8);
        if (c < 31) { const bf16_t* rp = P1 + ((size_t)b * SEQ + (c + 1) * 64 + lt) * LD1;
            rq = *(const u32x4*)(rp + A_Q + h * 64 + c8 * 8); rk = *(const u32x4*)(rp + A_K + h * 64 + c8 * 8); rg = *(const u32x4*)(rp + A_GK + h * 64 + c8 * 8);
            rv0 = *(const u32x4*)(rp + A_V + h * 128 + c8 * 8); rv1 = *(const u32x4*)(rp + A_V + h * 128 + 64 + c8 * 8); }
        __syncthreads();
        float cum[8]; { float run = 0.f;
#pragma unroll
            for (int i = 0; i < 8; ++i) { run += GK[(8 * seg + i) * 65 + kx]; cum[i] = run; }
            SEG[seg * 64 + kx] = run; }
        __syncthreads();
        { float off = 0.f, total = 0.f;
#pragma unroll
          for (int s = 0; s < 8; ++s) { const float v = SEG[s * 64 + kx]; total += v; if (s < seg) off += v; }
          float kd[8];
#pragma unroll
          for (int i = 0; i < 8; ++i) kd[i] = bf2f(Kb[(8 * seg + i) * 64 + kx]) * __expf(total - (off + cum[i]));
          u32x4 wv; wv.x = pk2(kd[0], kd[1]); wv.y = pk2(kd[2], kd[3]); wv.z = pk2(kd[4], kd[5]); wv.w = pk2(kd[6], kd[7]);
          *(u32x4*)(KDT + kx * 72 + 8 * seg) = wv;
          if (seg == 0) TOT[kx] = __expf(total); }
        __syncthreads();
        { const int kb = w & 1, vb = w >> 1;
#pragma unroll
          for (int r = 0; r < 16; ++r) X[r] *= TOT[32 * kb + crow(r, hi)];
#pragma unroll
          for (int kk = 0; kk < 4; ++kk) { const bf16x8 a = *(const bf16x8*)(KDT + (32 * kb + j) * 72 + kk * 16 + hi * 8);
              const bf16_t* vp = VT + (16 * kk + 8 * hi + ((lane & 15) >> 2)) * 136 + 32 * vb + 16 * ((lane >> 4) & 1) + 4 * (lane & 3);
              const v4i16_t lo = __builtin_amdgcn_ds_read_tr16_b64_v4i16((LAS v4i16_t*)vp), hi4 = __builtin_amdgcn_ds_read_tr16_b64_v4i16((LAS v4i16_t*)(vp + 4 * 136));
              const bf16x8 bb = __builtin_shufflevector(lo, hi4, 0, 1, 2, 3, 4, 5, 6, 7);
              X = MFMA32(a, bb, X); }
          u32x4 xw0, xw1;
          xw0.x = pk2(X[0], X[1]); xw0.y = pk2(X[2], X[3]); xw0.z = pk2(X[4], X[5]); xw0.w = pk2(X[6], X[7]);
          xw1.x = pk2(X[8], X[9]); xw1.y = pk2(X[10], X[11]); xw1.z = pk2(X[12], X[13]); xw1.w = pk2(X[14], X[15]);
          const bf16x8 xs0 = __builtin_bit_cast(bf16x8, xw0), xs1 = __builtin_bit_cast(bf16x8, xw1);
#pragma unroll
          for (int tb = 0; tb < 2; ++tb) { f32x16 Y;
#pragma unroll
              for (int r = 0; r < 16; ++r) Y[r] = 0.f;
#pragma unroll
              for (int s2 = 0; s2 < 2; ++s2) { const bf16_t* qp = Qs + (32 * tb + j) * 72 + 32 * kb + 16 * s2 + 4 * hi;
                  const u32x2 qlo = *(const u32x2*)qp, qhi = *(const u32x2*)(qp + 8);
                  u32x4 qa; qa.x = qlo.x; qa.y = qlo.y; qa.z = qhi.x; qa.w = qhi.y;
                  Y = MFMA32(__builtin_bit_cast(bf16x8, qa), s2 ? xs1 : xs0, Y); }
#pragma unroll
              for (int r = 0; r < 16; ++r) Ys[(kb * 64 + 32 * tb + crow(r, hi)) * 132 + 32 * vb + j] = Y[r] * 0.125f; } }
        __syncthreads();
        { const int t = tid >> 3, vs = tid & 7; float y[16]; float sq = 0.f;
#pragma unroll
          for (int i = 0; i < 4; ++i) { const f32x4 v = *(const f32x4*)(Ys + t * 132 + vs * 16 + 4 * i) + *(const f32x4*)(Ys + (64 + t) * 132 + vs * 16 + 4 * i); y[4 * i] = v[0]; y[4 * i + 1] = v[1]; y[4 * i + 2] = v[2]; y[4 * i + 3] = v[3];
              sq += v[0] * v[0] + v[1] * v[1] + v[2] * v[2] + v[3] * v[3]; }
          sq += __shfl_xor(sq, 1); sq += __shfl_xor(sq, 2); sq += __shfl_xor(sq, 4);
          const float rs = rsqrtf(sq * (1.f / 128.f) + EPS);
          const size_t row = (size_t)b * SEQ + c * 64 + t;
          float o[16];
#pragma unroll
          for (int e = 0; e < 4; ++e) { const float ga = bflo(g0[e]), gb = bfhi(g0[e]), gc = bflo(g1[e]), gd = bfhi(g1[e]);
              o[2 * e] = y[2 * e] * rs * an[2 * e] * (ga * __builtin_amdgcn_rcpf(1.f + __expf(-ga)));
              o[2 * e + 1] = y[2 * e + 1] * rs * an[2 * e + 1] * (gb * __builtin_amdgcn_rcpf(1.f + __expf(-gb)));
              o[8 + 2 * e] = y[8 + 2 * e] * rs * an[8 + 2 * e] * (gc * __builtin_amdgcn_rcpf(1.f + __expf(-gc)));
              o[8 + 2 * e + 1] = y[8 + 2 * e + 1] * rs * an[8 + 2 * e + 1] * (gd * __builtin_amdgcn_rcpf(1.f + __expf(-gd))); }
          u32x4 w0, w1; w0.x = pk2(o[0], o[1]); w0.y = pk2(o[2], o[3]); w0.z = pk2(o[4], o[5]); w0.w = pk2(o[6], o[7]);
          w1.x = pk2(o[8], o[9]); w1.y = pk2(o[10], o[11]); w1.z = pk2(o[12], o[13]); w1.w = pk2(o[14], o[15]);
          *(u32x4*)(Ya + row * 512 + h * 128 + vs * 16) = w0; *(u32x4*)(Ya + row * 512 + h * 128 + vs * 16 + 8) = w1; }
    }
}

DI void mixer_C(int job, const bf16_t* P1, const float* __restrict__ conv_w, const float* __restrict__ conv_b, const float* __restrict__ w_a, const float* __restrict__ b_a,
                const float* __restrict__ w_x, const float* __restrict__ b_x, const float* __restrict__ lam, bf16_t* Yc, unsigned char* lds) {
    const int tid = opaque_tid(), lane = tid & 63, w = __builtin_amdgcn_readfirstlane(tid >> 6), j = lane & 31, hi = lane >> 5;
    const int b = job >> 3, g = job & 7;
    bf16_t* XC = (bf16_t*)lds;
    bf16_t* WA = XC + 64 * 72;
    bf16_t* WX = WA + 64 * 72;
    float* RI = (float*)(WX + 64 * 72);
    float* SEGA = RI + 2 * 64 * 65;
    float* SEGH = SEGA + 512;
    const int ch = tid & 63, seg = tid >> 6, cc = g * 64 + ch;
#pragma unroll
    for (int n = 0; n < 8; ++n) { const int idx = tid + 512 * n, i = idx >> 6, jj = idx & 63;
        WA[jj * 72 + i] = f2bf(w_a[(size_t)g * 4096 + idx]); WX[jj * 72 + i] = f2bf(w_x[(size_t)g * 4096 + idx]); }
    const float cw0 = conv_w[cc], cw1 = conv_w[512 + cc], cw2 = conv_w[1024 + cc], cw3 = conv_w[1536 + cc], cb = conv_b[cc];
    const float ba = b_a[cc], bxb = b_x[cc], spl = log1pf(expf(-lam[cc]));
    float hcar = 0.f;
    bf16_t* XIN = (bf16_t*)(SEGH + 512);
    bf16_t* GIN = XIN + 2 * 67 * 64;
    bf16_t* YOUT = GIN + 2 * 64 * 64;
    const int lt = tid >> 3, c8 = tid & 7;
    const bf16_t* xg = P1 + (size_t)b * SEQ * LD1 + C_X + g * 64 + c8 * 8;
    const bf16_t* gg = P1 + (size_t)b * SEQ * LD1 + C_G + g * 64 + c8 * 8;
    u32x4 rx, rh, rg;
    { const u32x4 x0 = *(const u32x4*)(xg + (size_t)lt * LD1), g0 = *(const u32x4*)(gg + (size_t)lt * LD1);
      *(u32x4*)(XIN + (3 + lt) * 64 + c8 * 8) = x0; *(u32x4*)(GIN + lt * 64 + c8 * 8) = g0;
      if (tid < 24) *(u32x4*)(XIN + (tid >> 3) * 64 + c8 * 8) = (u32x4){0u, 0u, 0u, 0u};
      rx = *(const u32x4*)(xg + (size_t)(64 + lt) * LD1); rg = *(const u32x4*)(gg + (size_t)(64 + lt) * LD1);
      rh = rx; if (tid < 24) rh = *(const u32x4*)(xg + (size_t)(61 + (tid >> 3)) * LD1); }
    __syncthreads();
    for (int tt = 0; tt < 32; ++tt) {
        const int t0 = tt * 64 + seg * 8, buf = tt & 1;
        float xl[11], gv[8];
#pragma unroll
        for (int m = 0; m < 11; ++m) xl[m] = bf2f(XIN[(buf * 67 + seg * 8 + m) * 64 + ch]);
#pragma unroll
        for (int i = 0; i < 8; ++i) gv[i] = bf2f(GIN[(buf * 64 + seg * 8 + i) * 64 + ch]);
        if (tt < 31) { *(u32x4*)(XIN + ((buf ^ 1) * 67 + 3 + lt) * 64 + c8 * 8) = rx; *(u32x4*)(GIN + ((buf ^ 1) * 64 + lt) * 64 + c8 * 8) = rg;
            if (tid < 24) *(u32x4*)(XIN + ((buf ^ 1) * 67 + (tid >> 3)) * 64 + c8 * 8) = rh; }
        if (tt < 30) { const size_t tn = (size_t)(tt + 2) * 64;
            rx = *(const u32x4*)(xg + (tn + lt) * LD1); rg = *(const u32x4*)(gg + (tn + lt) * LD1);
            if (tid < 24) rh = *(const u32x4*)(xg + (tn - 3 + (tid >> 3)) * LD1); }
        float xc[8];
#pragma unroll
        for (int i = 0; i < 8; ++i) { xc[i] = cb + cw0 * xl[i] + cw1 * xl[i + 1] + cw2 * xl[i + 2] + cw3 * xl[i + 3]; XC[(seg * 8 + i) * 72 + ch] = f2bf(xc[i]); }
        __syncthreads();
        if (tt > 0) *(u32x4*)(Yc + ((size_t)b * SEQ + (tt - 1) * 64 + lt) * 512 + g * 64 + c8 * 8) = *(const u32x4*)(YOUT + lt * 64 + c8 * 8);
        { const int mat = w & 1, jb = (w >> 1) & 1, tb = w >> 2; const bf16_t* WM = mat ? WX : WA; f32x16 R;
#pragma unroll
          for (int r = 0; r < 16; ++r) R[r] = 0.f;
#pragma unroll
          for (int kk = 0; kk < 4; ++kk) { const bf16x8 a = *(const bf16x8*)(XC + (32 * tb + j) * 72 + kk * 16 + hi * 8), bb = *(const bf16x8*)(WM + (32 * jb + j) * 72 + kk * 16 + hi * 8);
              R = MFMA32(a, bb, R); }
#pragma unroll
          for (int r = 0; r < 16; ++r) RI[mat * 4160 + (32 * tb + crow(r, hi)) * 65 + 32 * jb + j] = R[r]; }
        __syncthreads();
        float hl[8], pp[8]; { float hh = 0.f, pr = 1.f;
#pragma unroll
          for (int i = 0; i < 8; ++i) { const float rv = __builtin_amdgcn_rcpf(1.f + __expf(-(RI[(seg * 8 + i) * 65 + ch] + ba))), iv = __builtin_amdgcn_rcpf(1.f + __expf(-(RI[4160 + (seg * 8 + i) * 65 + ch] + bxb)));
              const float la = -8.f * rv * spl, a = __expf(la), x2 = 2.f * la;
              const float ser = -x2 * (1.f + x2 * 0.5f * (1.f + x2 * (1.f / 3.f) * (1.f + x2 * 0.25f * (1.f + x2 * 0.2f))));
              const float om = x2 > -0.1f ? ser : 1.f - a * a;
              const float mult = __builtin_amdgcn_sqrtf(fmaxf(om, 0.f)), bx = mult * (iv * xc[i]);
              hh = a * hh + bx; pr *= a; hl[i] = hh; pp[i] = pr; }
          SEGA[seg * 64 + ch] = pr; SEGH[seg * 64 + ch] = hh; }
        __syncthreads();
        float hc = hcar, hf = hcar;
#pragma unroll
        for (int s = 0; s < 8; ++s) { const float sa = SEGA[s * 64 + ch], sh = SEGH[s * 64 + ch]; hf = sa * hf + sh; if (s < seg) hc = sa * hc + sh; }
        hcar = hf;
#pragma unroll
        for (int i = 0; i < 8; ++i) { const float hv = hl[i] + pp[i] * hc; const float x = gv[i];
            const float u = 0.7978845608f * (x + 0.044715f * x * x * x); const float th = 1.f - 2.f * __builtin_amdgcn_rcpf(1.f + __expf(2.f * u));
            YOUT[(seg * 8 + i) * 64 + ch] = f2bf(0.5f * x * (1.f + th) * hv); }
    }
    __syncthreads();
    *(u32x4*)(Yc + ((size_t)b * SEQ + 31 * 64 + lt) * 512 + g * 64 + c8 * 8) = *(const u32x4*)(YOUT + lt * 64 + c8 * 8);
}

DI void rs_fill(LAS float* rst, const float* ssp, int grp) {
    const int tid = opaque_tid();
#pragma unroll
    for (int i = 0; i < 4; ++i) { const int r = tid + 512 * i; rst[r] = rsqrtf(ss_row(ssp, grp * 2048 + r) * (1.f / 1024.f) + EPS); }
    __syncthreads();
}

#ifndef RA
#define RA 1
#endif
#ifndef RC
#define RC 1
#endif
#ifndef RD
#define RD 1
#endif
#ifndef RB
#define RB 1
#endif
constexpr int NJ_A = 32 * RA, NJ_C = 64 * RC, NJ_D = 512 * RD, NJ_B = 512 * RB, NJOBS = NJ_A + NJ_C + NJ_D + NJ_B;

__global__ void __launch_bounds__(512, 2) fwd_megakernel(Params p) {
    extern __shared__ __attribute__((aligned(16))) unsigned char lds[];
    cg::grid_group grid = cg::this_grid();
    unsigned char* ws = p.ws;
    LAS unsigned char* llds = (LAS unsigned char*)lds;
    const int G = gridDim.x, tid = threadIdx.x;
    float* ss = (float*)(ws + WS_SSP);
    bf16_t* P1 = (bf16_t*)(ws + WS_P1); bf16_t* P2 = (bf16_t*)(ws + WS_P2); bf16_t* Y = (bf16_t*)(ws + WS_Y); bf16_t* HB = (bf16_t*)(ws + WS_HB);
    bf16_t* MX = P1;
    bf16_t* U = P1;
    unsigned* jobctr = (unsigned*)(ws + WS_CTL);
    if (tid < 2) ((volatile LAS unsigned*)(llds + XBST))[tid] = 0u;
    __syncthreads();
    const XcdBarrier xbar = xcd_barrier_post((unsigned*)(ws + WS_BAR), (volatile LAS unsigned*)(llds + XBST));
#define GSYNC() xcd_barrier(xbar)

#ifndef NO_P0
    for (int rep = 0; rep < REP_P0; ++rep) { if (rep) grid.sync(); phase0(p, lds); }
#endif
    if (gridDim.y == 7u) grid.sync();
    GSYNC();

    for (int l = 0; l < NL; ++l) {
#ifndef NO_G1
        for (int rep = 0; rep < REP_G1; ++rep) {
            if (rep) GSYNC();
            pg8::Gemm g{HB, (const bf16_t*)(ws + WS_W1 + l * SZ_W1), T, NIN, DM, 0, 0, 1}; pg8::StaticOrder S; S.init(T, NIN, G, (int)blockIdx.x, 1);
            rs_fill((LAS float*)(llds + RS_OFF), ss + (size_t)(2 * l) * T * 16, (int)blockIdx.x & 7);
            pg8::EpiProj E{P1, P2, (const LAS float*)(llds + RS_OFF)};
            pg8::gemm_phase<pg8::EpiProj, true>(llds, g, S, E);
        }
#endif
        GSYNC();
        for (int rep = 0; rep < REP_MIX; ++rep) {
            if (rep) GSYNC();
            for (;;) {
                __syncthreads();
                if (tid == 0) *(volatile int*)(lds + JOBSLOT) = (int)atomicAdd(jobctr + l + 4 * rep, 1u);
                __syncthreads();
                const int job = *(volatile int*)(lds + JOBSLOT);
                if (job >= NJOBS) break;
#ifndef NO_MA
                if (job < NJ_A) mixer_A(job % 32, P1, p.a_b_gk + l * 256, p.a_norm + l * 128, Y, lds);
                else
#endif
#ifndef NO_MC
                if (job < NJ_A + NJ_C) mixer_C((job - NJ_A) % 64, P1, p.c_conv_w + l * 2048, p.c_conv_b + l * 512, p.c_w_a + (size_t)l * 32768, p.c_b_a + l * 512, p.c_w_x + (size_t)l * 32768, p.c_b_x + l * 512, p.c_lambda + l * 512, Y + (size_t)2 * T * 512, lds);
                else
#endif
#ifndef NO_MD
                if (job < NJ_A + NJ_C + NJ_D) mixer_D((job - NJ_A - NJ_C) % 512, P1, Y + (size_t)3 * T * 512, lds);
                else
#endif
#ifndef NO_MB
                mixer_B((job - NJ_A - NJ_C - NJ_D) % 512, P1, p.b_rel + l * 8 * 257, Y + (size_t)1 * T * 512, lds);
#endif
                ;
            }
        }
        GSYNC();
#ifndef NO_G3
        for (int rep = 0; rep < REP_G3; ++rep) {
            if (rep) GSYNC();
            pg8::Gemm g{Y, (const bf16_t*)(ws + WS_WB + l * SZ_WB), T, DM, 512, (size_t)T * 512 * 2, (size_t)DM * 512 * 2, 4}; pg8::StaticOrder S; S.init(T, DM, G, (int)blockIdx.x, 4);
            pg8::EpiMerge E{P2, MX};
            pg8::gemm_phase<pg8::EpiMerge, true>(llds, g, S, E);
        }
#endif
        GSYNC();
#ifndef NO_G4
        {
            pg8::Gemm g{MX, (const bf16_t*)(ws + WS_WO + l * SZ_WO), T, DM, DM, 0, 0, 1}; pg8::StaticOrder S; S.init(T, DM, G, (int)blockIdx.x, 1);
            pg8::EpiResid E{l == 0 ? p.x : nullptr, (const bf16_t*)p.out  , nullptr, Y  , HB, ss + (size_t)(2 * l + 1) * T * 16};
            pg8::gemm_phase<pg8::EpiResid, true>(llds, g, S, E);
        }
#endif
        GSYNC();
#ifdef XSYNC
        for (int q = 0; q < XSYNC; ++q) GSYNC();
#endif
#ifndef NO_G5
        for (int rep = 0; rep < REP_G5; ++rep) {
            if (rep) GSYNC();
            pg8::Gemm g{HB, (const bf16_t*)(ws + WS_WGU + l * SZ_WGU), T, NGU, DM, 0, 0, 1}; pg8::StaticOrder S; S.init(T, NGU, G, (int)blockIdx.x, 1);
            rs_fill((LAS float*)(llds + RS_OFF), ss + (size_t)(2 * l + 1) * T * 16, (int)blockIdx.x & 7);
            pg8::EpiFfn E{U, (const LAS float*)(llds + RS_OFF)};
            pg8::gemm_phase<pg8::EpiFfn, true>(llds, g, S, E);
        }
#endif
        GSYNC();
#ifndef NO_G6
        {
            pg8::Gemm g{U, (const bf16_t*)(ws + WS_WD + l * SZ_WD), T, DM, FF, 0, 0, 1}; pg8::StaticOrder S; S.init(T, DM, G, (int)blockIdx.x, 1);
            pg8::EpiResid E{nullptr, Y, l == NL - 1 ? p.out : nullptr, (bf16_t*)p.out, HB, ss + (size_t)(2 * l + 2) * T * 16};
            pg8::gemm_phase<pg8::EpiResid, true>(llds, g, S, E);
        }
#endif
        GSYNC();
    }
    {
        const int lane = tid & 63, gw = blockIdx.x * 8 + (tid >> 6), nw = G * 8; const float* ssf = ss + (size_t)8 * T * 16;
        for (int row = gw; row < T; row += nw) { const float rs = rsqrtf(ss_row(ssf, row) * (1.f / 1024.f) + EPS);
#pragma unroll
            for (int i = 0; i < 4; ++i) { const size_t o = (size_t)row * DM + i * 256 + lane * 4; f32x4 v = *(const f32x4*)(p.out + o); const f32x4 gn = *(const f32x4*)(p.norm_final + i * 256 + lane * 4);
                v[0] *= rs * gn[0]; v[1] *= rs * gn[1]; v[2] *= rs * gn[2]; v[3] *= rs * gn[3]; *(f32x4*)(p.out + o) = v; } }
    }
}

extern "C" void kernel_launch(void* const* d_in, const int* in_sizes, int n_in, void* d_out, int out_size, void* d_ws, size_t ws_size, hipStream_t stream) {
    static int grid_blocks = 0;
    if (grid_blocks == 0) {
        if (n_in != 21 || out_size != T * DM || ws_size < WS_END) { fprintf(stderr, "kernel_launch: unexpected shapes (n_in %d out %d ws %zu need %zu)\n", n_in, out_size, ws_size, (size_t)WS_END); grid_blocks = -1; return; }
        int dev = 0, cus = 0, per_cu = 0;
        hipGetDevice(&dev);
        hipDeviceGetAttribute(&cus, hipDeviceAttributeMultiprocessorCount, dev);
        if (hipFuncSetAttribute((const void*)fwd_megakernel, hipFuncAttributeMaxDynamicSharedMemorySize, LDS_BYTES) != hipSuccess) { fprintf(stderr, "kernel_launch: hipFuncSetAttribute failed\n"); grid_blocks = -1; return; }
        if (hipOccupancyMaxActiveBlocksPerMultiprocessor(&per_cu, (const void*)fwd_megakernel, 512, LDS_BYTES) != hipSuccess || per_cu < 1) { fprintf(stderr, "kernel_launch: occupancy query failed (%d)\n", per_cu); per_cu = 1; }
        (void)hipGetLastError();
        grid_blocks = cus * per_cu;
    }
    if (grid_blocks < 0) return;
    Params p{};
    p.x = (const float*)d_in[0]; p.norm_mix = (const float*)d_in[1]; p.w_in = (const float*)d_in[2]; p.a_w_gk = (const float*)d_in[3]; p.a_b_gk = (const float*)d_in[4]; p.a_norm = (const float*)d_in[5];
    p.b_rel = (const float*)d_in[6]; p.c_conv_w = (const float*)d_in[7]; p.c_conv_b = (const float*)d_in[8]; p.c_w_a = (const float*)d_in[9]; p.c_b_a = (const float*)d_in[10]; p.c_w_x = (const float*)d_in[11];
    p.c_b_x = (const float*)d_in[12]; p.c_lambda = (const float*)d_in[13]; p.w_branch = (const float*)d_in[14]; p.w_out = (const float*)d_in[15]; p.norm_ffn = (const float*)d_in[16];
    p.w_gate = (const float*)d_in[17]; p.w_up = (const float*)d_in[18]; p.w_down = (const float*)d_in[19]; p.norm_final = (const float*)d_in[20];
    p.out = (float*)d_out; p.ws = (unsigned char*)d_ws;
    if (hipMemsetAsync((char*)d_ws + WS_CTL, 0, CTL_ZERO_BYTES, stream) != hipSuccess) { fprintf(stderr, "kernel_launch: memset failed\n"); return; }
    void* args[] = {&p};
    hipError_t e = hipLaunchCooperativeKernel((const void*)fwd_megakernel, dim3(grid_blocks), dim3(512), args, LDS_BYTES, stream);
    if (e != hipSuccess) fprintf(stderr, "cooperative launch failed: %s (grid %d)\n", hipGetErrorString(e), grid_blocks);
}
```

```cpp
#include <hip/hip_runtime.h>
#include <hip/hip_cooperative_groups.h>
#include <cstdio>
#include <cstdint>
namespace cg = cooperative_groups;

#define LAS __attribute__((address_space(3)))
typedef unsigned short bf16_t;
typedef short bf16x8 __attribute__((ext_vector_type(8)));
typedef float f32x4 __attribute__((ext_vector_type(4)));
typedef float f32x16 __attribute__((ext_vector_type(16)));
typedef unsigned u32x4 __attribute__((ext_vector_type(4)));
typedef unsigned u32x2 __attribute__((ext_vector_type(2)));
typedef float f32x2 __attribute__((ext_vector_type(2)));
typedef __bf16 bf16x2_t __attribute__((ext_vector_type(2)));
#define DI __device__ __forceinline__

constexpr int T = 16384, SEQ = 2048, DM = 1024, NL = 4;
constexpr int NORIG = 9744, NIN = 9984, LD1 = 5888, LD2 = 4096, FF = 2816, NGU = 5632;
constexpr int A_Q = 0, A_K = 256, A_V = 512, A_GK = 1024, A_G = 1280, B_Q = 1792, B_K = 2304, B_V = 2816, C_G = 3328, C_X = 3840, D_Q = 4352, D_K = 4864, D_V = 5376;
constexpr float EPS = 1e-6f;
constexpr size_t WS_CTL = 0, WS_SS = 4096, WS_W1 = 1u << 20;
constexpr size_t SZ_W1 = (size_t)NIN * DM * 2, SZ_WB = (size_t)4 * DM * 512 * 2, SZ_WO = (size_t)DM * DM * 2, SZ_WGU = (size_t)NGU * DM * 2, SZ_WD = (size_t)DM * FF * 2;
constexpr size_t WS_WB = WS_W1 + NL * SZ_W1, WS_WO = WS_WB + NL * SZ_WB, WS_WGU = WS_WO + NL * SZ_WO, WS_WD = WS_WGU + NL * SZ_WGU;
constexpr size_t WS_P1 = WS_WD + NL * SZ_WD, WS_P2 = WS_P1 + (size_t)T * LD1 * 2, WS_Y = WS_P2 + (size_t)T * LD2 * 2, WS_HB = WS_Y + (size_t)4 * T * 512 * 2, WS_SSP = WS_HB + (size_t)T * DM * 2, WS_END = WS_SSP + (size_t)9 * T * 64;
static_assert(WS_END <= 638582784ull, "workspace");
constexpr int LDS_BYTES = 147456, JOBSLOT = 140000, XBST = 140016, RS_OFF = 131072;
constexpr size_t WS_BAR = 4096, CTL_ZERO_BYTES = 32768;
#ifndef REP_MIX
#define REP_MIX 1
#endif
#ifndef REP_G1
#define REP_G1 1
#endif
#ifndef REP_G3
#define REP_G3 1
#endif
#ifndef REP_G5
#define REP_G5 1
#endif
#ifndef REP_P0
#define REP_P0 1
#endif

DI int opaque_tid() { int t = threadIdx.x; asm volatile("" : "+v"(t)); return t; }
DI unsigned pk2(float lo, float hi) { f32x2 v = {lo, hi}; bf16x2_t b = __builtin_convertvector(v, bf16x2_t); return __builtin_bit_cast(unsigned, b); }
DI float bflo(unsigned w) { return __uint_as_float(w << 16); }
DI float bfhi(unsigned w) { return __uint_as_float(w & 0xffff0000u); }
DI float bf2f(bf16_t v) { return __uint_as_float((unsigned)v << 16); }
DI bf16_t f2bf(float f) { return (bf16_t)(pk2(f, 0.f) & 0xffffu); }
DI float ss_row(const float* ssp, int row) { const f32x4* sp = (const f32x4*)(ssp + (size_t)row * 16); float s = 0.f;
#pragma unroll
    for (int q = 0; q < 4; ++q) { const f32x4 v = sp[q]; s += (v[0] + v[1]) + (v[2] + v[3]); } return s; }
DI int crow(int r, int hi) { return (r & 3) + 8 * (r >> 2) + 4 * hi; }
DI float sigmoidf_(float x) { return 1.f / (1.f + __expf(-x)); }
#define MFMA32(a, b, c) __builtin_amdgcn_mfma_f32_32x32x16_bf16((a), (b), (c), 0, 0, 0)


#define XB_TMO      128
#define XB_XCNT(j)  (256  + 64 * (j))
#define XB_XSUB(j)  (1280 + 64 * (j))
#define XB_XGEN(j)  (2304 + 64 * (j))
#define XB_TOP      3328
#define XB_TOPGEN   3392
#define XCD_BAR_WORDS 3456
#define XB_SPIN_CAP (1u << 22)
DI unsigned xb_ld(unsigned* p)              { return __hip_atomic_load(p, __ATOMIC_RELAXED, __HIP_MEMORY_SCOPE_AGENT); }
DI unsigned xb_add(unsigned* p, unsigned v) { return __hip_atomic_fetch_add(p, v, __ATOMIC_RELAXED, __HIP_MEMORY_SCOPE_AGENT); }
DI unsigned xb_xcc_id() { return (unsigned)__builtin_amdgcn_s_getreg((3 << 11) | 20) & 0xFu; }
#define XB_SPIN(cond, bar) do { unsigned _sp = 0; while (cond) { __builtin_amdgcn_s_sleep(1); \
    if ((++_sp & 255u) == 0u) { if (xb_ld(&(bar)[XB_TMO])) break; if (_sp > XB_SPIN_CAP) { atomicAdd(&(bar)[XB_TMO], 1u); break; } } } } while (0)
struct XcdBarrier { unsigned* bar; unsigned x; volatile LAS unsigned* st; };
DI XcdBarrier xcd_barrier_post(unsigned* bar, volatile LAS unsigned* st) {
    XcdBarrier b; b.bar = bar; b.x = xb_xcc_id(); b.st = st;
    if (threadIdx.x == 0) (void)xb_add(&bar[XB_XCNT(b.x)], 1u);
    return b;
}
DI void xcd_barrier_complete(unsigned* bar, unsigned x, unsigned& nloc, unsigned& nx) {
    const unsigned G = gridDim.x * gridDim.y * gridDim.z;
    unsigned sum, cnt, mine, sp = 0u;
    for (;;) {
        sum = 0u; cnt = 0u; mine = 0u;
#pragma unroll
        for (unsigned j = 0; j < 16; ++j) { const unsigned c = xb_ld(&bar[XB_XCNT(j)]); sum += c; cnt += (c > 0u) ? 1u : 0u; mine = (j == x) ? c : mine; }
        if (sum == G) break;
        __builtin_amdgcn_s_sleep(1);
        if ((++sp & 255u) == 0u) { if (xb_ld(&bar[XB_TMO])) break; if (sp > XB_SPIN_CAP) { atomicAdd(&bar[XB_TMO], 1u); break; } }
    }
    nloc = mine > 0u ? mine : 1u; nx = cnt > 0u ? cnt : 1u;
}
DI void xcd_barrier(const XcdBarrier& b) {
    asm volatile("s_waitcnt vmcnt(0)" ::: "memory");
    __syncthreads();
    if (threadIdx.x == 0) {
        unsigned* bar = b.bar;
        __builtin_amdgcn_s_waitcnt(0);
        unsigned nloc = b.st[0], nx = b.st[1];
        if (nloc == 0u) { xcd_barrier_complete(bar, b.x, nloc, nx); b.st[0] = nloc; b.st[1] = nx; }
        const unsigned old = xb_add(&bar[XB_XSUB(b.x)], 1u);
        const unsigned gen = old / nloc;
        if (old + 1u == (gen + 1u) * nloc) {
            __builtin_amdgcn_fence(__ATOMIC_RELEASE, "agent");
            asm volatile("s_waitcnt vmcnt(0)" ::: "memory");
            const unsigned og = xb_add(&bar[XB_TOP], 1u);
            const unsigned tg = og / nx;
            if (og + 1u == (tg + 1u) * nx) xb_add(&bar[XB_TOPGEN], 1u);
            else XB_SPIN(xb_ld(&bar[XB_TOPGEN]) == tg, bar);
            __builtin_amdgcn_fence(__ATOMIC_ACQUIRE, "agent");
            xb_add(&bar[XB_XGEN(b.x)], 1u);
            asm volatile("s_waitcnt vmcnt(0)" ::: "memory");
        } else {
            XB_SPIN(xb_ld(&bar[XB_XGEN(b.x)]) == gen, bar);
            __builtin_amdgcn_fence(__ATOMIC_ACQUIRE, "agent");
            asm volatile("s_waitcnt vmcnt(0)" ::: "memory");
        }
    }
    __syncthreads();
}

namespace pg8 {
constexpr int BM = 256, BK = 64, HALF = 128, HTB = HALF * BK * 2, NXCD = 8, WGM = 8;
DI int lds_byte(int r, int c) { const int st = (r >> 4) * 2 + (c >> 5), rr = r & 15, cc = c & 31, ob = rr * 64 + cc * 2; return st * 1024 + (ob ^ (((ob >> 9) & 1) << 5)); }
DI void stage_rc(int b, int& R, int& C) { const int st = b / 1024, sb = b % 1024, swz = sb ^ (((sb >> 9) & 1) << 5); R = (st >> 1) * 16 + swz / 64; C = (st & 1) * 32 + (swz % 64) / 2; }
DI int perm32(int rho) { const int n = rho >> 4, i = rho & 15; return 8 * (i >> 2) + 4 * n + (i & 3); }

struct Unit { int pm, pn, br; };
struct Gemm { const bf16_t* A; const bf16_t* Bt; int M, N, K; size_t brA, brB; int nbr; };

struct StaticOrder {
    int nN, nwg, G, c, sh;
    DI void init(int M, int N, int G_, int c_, int nbr_) { nN = N / BM; nwg = (M / BM) * nN; G = G_; c = c_; sh = nbr_ == 4 ? 2 : 0; }
    DI bool next(int i, Unit& u) const {
        const int ti = i >> sh; u.br = i & ((1 << sh) - 1);
        const int L = ti * G + c; if (L >= nwg) return false;
        int wgid = L; { const int q = nwg / NXCD, r = nwg % NXCD, xcd = wgid % NXCD, off = wgid / NXCD; wgid = (xcd < r ? xcd * (q + 1) : r * (q + 1) + (xcd - r) * q) + off; }
        const int nig = WGM * nN, gid = wgid / nig, rem = wgid - gid * nig;
        u.pm = gid * WGM + (rem & 7); u.pn = rem >> 3; return true;
    }
};

template <class Epi, bool ALIGN_EPI>
DI void gemm_phase(LAS unsigned char* lds, const Gemm g, const StaticOrder& S, const Epi& E) {
    const int tid = opaque_tid(), wid = __builtin_amdgcn_readfirstlane(tid >> 6), lane = tid & 63, wr = wid >> 2, wc = wid & 3, fr = lane & 15, fq = lane >> 4;
    const int K = g.K, nt = K / BK;
    unsigned voffA[2], voffB[2];
#pragma unroll
    for (int i = 0; i < 2; ++i) { int R, C; stage_rc(tid * 16 + i * 8192, R, C); const int Rb = Epi::PERM ? ((R & ~31) + perm32(R & 31)) : R;
        voffA[i] = (unsigned)(R * K + C) * 2u; voffB[i] = (unsigned)(Rb * K + C) * 2u; }
    const size_t kstep = (size_t)(BK * 2);
    const size_t hstep = (size_t)HALF * K * 2;
    const size_t tstep = 2 * hstep;
    const unsigned ldsw = (unsigned)wid * 1024u;
    const int aoff = lds_byte(wr * 64 + fr, fq * 8), boff = lds_byte(wc * 32 + fr, fq * 8);
#define PG8_SA(b, h) (((b) * 2 + (h)) * HTB)
#define PG8_SB(b, h) ((4 + (b) * 2 + (h)) * HTB)
#define PG8_STAGE(bufoff, gbase, voff) do { _Pragma("unroll") for (int _i = 0; _i < 2; ++_i) \
        __builtin_amdgcn_global_load_lds((const unsigned*)((const char*)(gbase) + (voff)[_i]), (LAS unsigned*)(lds + (bufoff) + ldsw + _i * 8192), 16, 0, 0); } while (0)
#define PG8_LDA(dst, b, h) do { _Pragma("unroll") for (int m = 0; m < 4; ++m) _Pragma("unroll") for (int k = 0; k < 2; ++k) dst[m][k] = *(const LAS bf16x8*)(lds + PG8_SA(b, h) + aoff + m * 2048 + k * 1024); } while (0)
#define PG8_LDB(dst, b, h) do { _Pragma("unroll") for (int n = 0; n < 2; ++n) _Pragma("unroll") for (int k = 0; k < 2; ++k) dst[n][k] = *(const LAS bf16x8*)(lds + PG8_SB(b, h) + boff + n * 2048 + k * 1024); } while (0)
#define PG8_MMA(ai, bj, At, Bt) do { __builtin_amdgcn_s_setprio(1); _Pragma("unroll") for (int m = 0; m < 4; ++m) _Pragma("unroll") for (int n = 0; n < 2; ++n) _Pragma("unroll") for (int k = 0; k < 2; ++k) \
        acc[ai][bj][m][n] = __builtin_amdgcn_mfma_f32_16x16x32_bf16(Bt[n][k], At[m][k], acc[ai][bj][m][n], 0, 0, 0); __builtin_amdgcn_s_setprio(0); } while (0)
#define PG8_WAIT_V(n) asm volatile("s_waitcnt vmcnt(" #n ")" ::: "memory")
#define PG8_WAIT_L(n) asm volatile("s_waitcnt lgkmcnt(" #n ")" ::: "memory")
#define PG8_BAR __builtin_amdgcn_s_barrier()
#define PG8_SCHED __builtin_amdgcn_sched_barrier(0)
#define PG8_ZERO() do { _Pragma("unroll") for (int a = 0; a < 2; ++a) _Pragma("unroll") for (int b = 0; b < 2; ++b) _Pragma("unroll") for (int m = 0; m < 4; ++m) _Pragma("unroll") for (int n = 0; n < 2; ++n) acc[a][b][m][n] = (f32x4){0.f, 0.f, 0.f, 0.f}; } while (0)
    Unit cur, nxt; int ui = 0;
    if (!S.next(0, cur)) return;
    f32x4 acc[2][2][4][2];
    if constexpr (Epi::INIT) E.init(acc, cur, wr, wc, fr, fq); else PG8_ZERO();
    bf16x8 At[4][2], B0[2][2], B1[2][2];
    const char* cA = (const char*)g.A + (size_t)cur.pm * tstep + (size_t)cur.br * g.brA; const char* cB = (const char*)g.Bt + (size_t)cur.pn * tstep + (size_t)cur.br * g.brB;
    PG8_STAGE(PG8_SB(0, 0), cB, voffB); PG8_STAGE(PG8_SB(0, 1), cB + hstep, voffB); PG8_STAGE(PG8_SA(0, 0), cA, voffA); PG8_STAGE(PG8_SA(0, 1), cA + hstep, voffA);
    if (wr == 1) PG8_BAR;
    PG8_WAIT_V(2); PG8_BAR;
    PG8_STAGE(PG8_SB(1, 0), cB + kstep, voffB); PG8_STAGE(PG8_SA(1, 0), cA + kstep, voffA); PG8_STAGE(PG8_SB(1, 1), cB + hstep + kstep, voffB);
    PG8_WAIT_V(6); PG8_BAR;
    for (;;) {
        const bool has_next = S.next(ui + 1, nxt);
        const char* nA = has_next ? (const char*)g.A + (size_t)nxt.pm * tstep + (size_t)nxt.br * g.brA : cA; const char* nB = has_next ? (const char*)g.Bt + (size_t)nxt.pn * tstep + (size_t)nxt.br * g.brB : cB;
        for (int t = 0; t < nt; t += 2) {
            const bool last = (t == nt - 2);
            const char* a1 = cA + (size_t)(t + 1) * kstep;
            const char* a2 = last ? nA : cA + (size_t)(t + 2) * kstep; const char* b2 = last ? nB : cB + (size_t)(t + 2) * kstep;
            const char* a3 = a2 + kstep; const char* b3 = b2 + kstep;
            PG8_LDB(B0, 0, 0); PG8_LDB(B1, 0, 1); PG8_SCHED; PG8_LDA(At, 0, 0); PG8_STAGE(PG8_SA(1, 1), a1 + hstep, voffA);
            PG8_WAIT_V(8); PG8_WAIT_L(0); PG8_BAR; PG8_MMA(0, 0, At, B0); PG8_MMA(0, 1, At, B1); PG8_BAR; PG8_SCHED;
            PG8_LDA(At, 0, 1); PG8_STAGE(PG8_SB(0, 0), b2, voffB); PG8_STAGE(PG8_SB(0, 1), b2 + hstep, voffB); PG8_STAGE(PG8_SA(0, 0), a2, voffA);
            PG8_WAIT_V(8); PG8_WAIT_L(0); PG8_BAR; PG8_MMA(1, 0, At, B0); PG8_MMA(1, 1, At, B1); PG8_BAR; PG8_SCHED;
            PG8_LDB(B0, 1, 0); PG8_LDB(B1, 1, 1); PG8_SCHED; PG8_LDA(At, 1, 0); PG8_STAGE(PG8_SA(0, 1), a2 + hstep, voffA);
            PG8_WAIT_V(8); PG8_WAIT_L(0); PG8_BAR; PG8_MMA(0, 0, At, B0); PG8_MMA(0, 1, At, B1); PG8_BAR; PG8_SCHED;
            PG8_LDA(At, 1, 1); PG8_STAGE(PG8_SB(1, 0), b3, voffB); PG8_STAGE(PG8_SB(1, 1), b3 + hstep, voffB); PG8_STAGE(PG8_SA(1, 0), a3, voffA);
            PG8_WAIT_V(8); PG8_WAIT_L(0); PG8_BAR; PG8_MMA(1, 0, At, B0); PG8_MMA(1, 1, At, B1); PG8_BAR; PG8_SCHED;
        }
        if constexpr (ALIGN_EPI) { if (wr == 0) PG8_BAR; }
        E(acc, cur, wr, wc, fr, fq);
        if (!has_next) break;
        if constexpr (Epi::INIT) E.init(acc, nxt, wr, wc, fr, fq); else if (!(Epi::MULTI && nxt.br != 0)) PG8_ZERO();
        cur = nxt; cA = nA; cB = nB; ++ui;
        if constexpr (ALIGN_EPI) { if (wr == 1) PG8_BAR; }
    }
    PG8_WAIT_V(0);
    if constexpr (!ALIGN_EPI) { if (wr == 0) PG8_BAR; }
    PG8_BAR;
#undef PG8_SA
#undef PG8_SB
#undef PG8_STAGE
#undef PG8_LDA
#undef PG8_LDB
#undef PG8_MMA
#undef PG8_WAIT_V
#undef PG8_WAIT_L
#undef PG8_BAR
#undef PG8_SCHED
#undef PG8_ZERO
}

struct EpiProj {
    static constexpr bool PERM = true, MULTI = false, INIT = false;
    bf16_t* P1; bf16_t* P2; const LAS float* rst;
    DI void operator()(f32x4 (&acc)[2][2][4][2], const Unit& u, int wr, int wc, int fr, int fq) const {
        const int row0 = u.pm * BM + wr * 64 + fr;
        bf16_t* base; int ldc, colt;
        if (u.pn < 23) { base = P1; ldc = LD1; colt = u.pn * BM; } else { base = P2; ldc = LD2; colt = (u.pn - 23) * BM; }
        const int col0 = colt + wc * 64 + 8 * fq;
#pragma unroll
        for (int ai = 0; ai < 2; ++ai)
#pragma unroll
            for (int m = 0; m < 4; ++m) { const int row = row0 + ai * HALF + m * 16; const float rs = rst[row & 2047];
                bf16_t* rowp = base + (size_t)row * ldc + col0;
                if (u.pn >= 23) {
                    u32x4 wq;
#pragma unroll
                    for (int bj = 0; bj < 2; ++bj) { const f32x4 v0 = acc[ai][bj][m][0] * rs, v1 = acc[ai][bj][m][1] * rs; unsigned q0 = 0u, q1 = 0u;
#pragma unroll
                        for (int e = 0; e < 4; ++e) {
                            const unsigned a = (unsigned)fmaxf(__builtin_amdgcn_rcpf(1.f + __expf(-v0[e])) * 255.f + 0.5f, 1.f), b = (unsigned)fmaxf(__builtin_amdgcn_rcpf(1.f + __expf(-v1[e])) * 255.f + 0.5f, 1.f);
                            q0 |= a << (8 * e); q1 |= b << (8 * e); }
                        if (bj == 0) { wq.x = q0; wq.y = q1; } else { wq.z = q0; wq.w = q1; } }
                    *(u32x4*)((unsigned char*)P2 + (size_t)row * LD2 + (u.pn - 23) * BM + wc * 64 + 16 * fq) = wq;
                } else {
#pragma unroll
                for (int bj = 0; bj < 2; ++bj) { const f32x4 v0 = acc[ai][bj][m][0] * rs, v1 = acc[ai][bj][m][1] * rs;
                    u32x4 w; w.x = pk2(v0[0], v0[1]); w.y = pk2(v0[2], v0[3]); w.z = pk2(v1[0], v1[1]); w.w = pk2(v1[2], v1[3]);
                    *(u32x4*)(rowp + bj * 32) = w; } } }
    }
};
struct EpiMerge {
    static constexpr bool PERM = true, MULTI = true, INIT = false;
    const bf16_t* P2; bf16_t* MX;
    DI void operator()(f32x4 (&acc)[2][2][4][2], const Unit& u, int wr, int wc, int fr, int fq) const {
        const int row0 = u.pm * BM + wr * 64 + fr, col0 = u.pn * BM + wc * 64 + 8 * fq, br = u.br;
#pragma unroll
        for (int ai = 0; ai < 2; ++ai)
#pragma unroll
            for (int m = 0; m < 4; ++m) { const int row = row0 + ai * HALF + m * 16;
                const unsigned char* gp = (const unsigned char*)P2 + (size_t)row * LD2 + br * 1024 + u.pn * BM + wc * 64 + 16 * fq;
                const u32x4 ga = *(const u32x4*)gp; u32x4 gb = ga; if (br < 3) gb = *(const u32x4*)(gp + 1024);
#pragma unroll
                for (int bj = 0; bj < 2; ++bj) { const int col = col0 + bj * 32;
                    float f[8];
#pragma unroll
                    for (int e = 0; e < 8; ++e) { const float a_ = (float)((ga[2 * bj + (e >> 2)] >> (8 * (e & 3))) & 0xffu);
                        f[e] = br < 3 ? a_ * __builtin_amdgcn_rcpf((float)((gb[2 * bj + (e >> 2)] >> (8 * (e & 3))) & 0xffu)) : a_ * (1.f / 255.f); }
                    f32x4 v0 = acc[ai][bj][m][0], v1 = acc[ai][bj][m][1];
                    v0[0] *= f[0]; v0[1] *= f[1]; v0[2] *= f[2]; v0[3] *= f[3]; v1[0] *= f[4]; v1[1] *= f[5]; v1[2] *= f[6]; v1[3] *= f[7];
                    acc[ai][bj][m][0] = v0; acc[ai][bj][m][1] = v1;
                    if (br == 3) { u32x4 w; w.x = pk2(v0[0], v0[1]); w.y = pk2(v0[2], v0[3]); w.z = pk2(v1[0], v1[1]); w.w = pk2(v1[2], v1[3]);
                        *(u32x4*)(MX + (size_t)row * DM + col) = w; } } }
    }
};
struct EpiResid {
    static constexpr bool PERM = true, MULTI = false, INIT = true;
    const float* rin32; const bf16_t* lin; float* hout32; bf16_t* lout; bf16_t* hb; float* ssn;
    DI void init(f32x4 (&acc)[2][2][4][2], const Unit& u, int wr, int wc, int fr, int fq) const {
        const int row0 = u.pm * BM + wr * 64 + fr, col0 = u.pn * BM + wc * 64 + 8 * fq;
#pragma unroll
        for (int ai = 0; ai < 2; ++ai)
#pragma unroll
            for (int m = 0; m < 4; ++m)
#pragma unroll
                for (int bj = 0; bj < 2; ++bj) { const size_t o = (size_t)(row0 + ai * HALF + m * 16) * DM + col0 + bj * 32;
                    if (rin32) { acc[ai][bj][m][0] = *(const f32x4*)(rin32 + o); acc[ai][bj][m][1] = *(const f32x4*)(rin32 + o + 4); }
                    else { const u32x4 hi = *(const u32x4*)(hb + o), lo = *(const u32x4*)(lin + o);
                        acc[ai][bj][m][0] = (f32x4){bflo(hi.x) + bflo(lo.x), bfhi(hi.x) + bfhi(lo.x), bflo(hi.y) + bflo(lo.y), bfhi(hi.y) + bfhi(lo.y)};
                        acc[ai][bj][m][1] = (f32x4){bflo(hi.z) + bflo(lo.z), bfhi(hi.z) + bfhi(lo.z), bflo(hi.w) + bflo(lo.w), bfhi(hi.w) + bfhi(lo.w)}; } }
    }
    DI void operator()(f32x4 (&acc)[2][2][4][2], const Unit& u, int wr, int wc, int fr, int fq) const {
        const int row0 = u.pm * BM + wr * 64 + fr, col0 = u.pn * BM + wc * 64 + 8 * fq;
#pragma unroll
        for (int ai = 0; ai < 2; ++ai)
#pragma unroll
            for (int m = 0; m < 4; ++m) { const int row = row0 + ai * HALF + m * 16; float sq = 0.f;
#pragma unroll
                for (int bj = 0; bj < 2; ++bj) { const size_t o = (size_t)row * DM + col0 + bj * 32;
                    const f32x4 v0 = acc[ai][bj][m][0], v1 = acc[ai][bj][m][1];
                    u32x4 w; w.x = pk2(v0[0], v0[1]); w.y = pk2(v0[2], v0[3]); w.z = pk2(v1[0], v1[1]); w.w = pk2(v1[2], v1[3]);
                    *(u32x4*)(hb + o) = w;
                    if (hout32) { *(f32x4*)(hout32 + o) = v0; *(f32x4*)(hout32 + o + 4) = v1; }
                    else { u32x4 l; l.x = pk2(v0[0] - bflo(w.x), v0[1] - bfhi(w.x)); l.y = pk2(v0[2] - bflo(w.y), v0[3] - bfhi(w.y));
                        l.z = pk2(v1[0] - bflo(w.z), v1[1] - bfhi(w.z)); l.w = pk2(v1[2] - bflo(w.w), v1[3] - bfhi(w.w));
                        *(u32x4*)(lout + o) = l; }
                    sq += v0[0] * v0[0] + v0[1] * v0[1] + v0[2] * v0[2] + v0[3] * v0[3] + v1[0] * v1[0] + v1[1] * v1[1] + v1[2] * v1[2] + v1[3] * v1[3]; }
                sq += __shfl_xor(sq, 16); sq += __shfl_xor(sq, 32);
                if (fq == 0) ssn[(size_t)row * 16 + u.pn * 4 + wc] = sq; }
    }
};
struct EpiFfn {
    static constexpr bool PERM = false, MULTI = false, INIT = false;
    bf16_t* U; const LAS float* rst;
    DI void operator()(f32x4 (&acc)[2][2][4][2], const Unit& u, int wr, int wc, int fr, int fq) const {
        const int row0 = u.pm * BM + wr * 64 + fr, col = 128 * u.pn + 32 * wc + 8 * fq;
#pragma unroll
        for (int ai = 0; ai < 2; ++ai)
#pragma unroll
            for (int m = 0; m < 4; ++m) { const int row = row0 + ai * HALF + m * 16; const float rs = rst[row & 2047]; float o[8];
#pragma unroll
                for (int bj = 0; bj < 2; ++bj) { const f32x4 gg = acc[ai][bj][m][0] * rs, uu = acc[ai][bj][m][1] * rs;
#pragma unroll
                    for (int e = 0; e < 4; ++e) o[4 * bj + e] = gg[e] * __builtin_amdgcn_rcpf(1.f + __expf(-gg[e])) * uu[e]; }
                u32x4 w; w.x = pk2(o[0], o[1]); w.y = pk2(o[2], o[3]); w.z = pk2(o[4], o[5]); w.w = pk2(o[6], o[7]);
                *(u32x4*)(U + (size_t)row * FF + col) = w; }
    }
};
}

struct Params {
    const float* x; const float* norm_mix; const float* w_in; const float* a_w_gk; const float* a_b_gk; const float* a_norm; const float* b_rel; const float* c_conv_w; const float* c_conv_b;
    const float* c_w_a; const float* c_b_a; const float* c_w_x; const float* c_b_x; const float* c_lambda; const float* w_branch; const float* w_out; const float* norm_ffn;
    const float* w_gate; const float* w_up; const float* w_down; const float* norm_final; float* out; unsigned char* ws;
};

struct TrItem { const float* src; const float* ksc; bf16_t* dst; int ld, c0, k0, ldd, mode, roff; };
constexpr int TR_IN = 608, TR_BR = 128, TR_OUT = 64, TR_G = 176, TR_U = 176, TR_D = 176, TR_PER = TR_IN + TR_BR + TR_OUT + TR_G + TR_U + TR_D, TR_GK = 64;
DI TrItem tr_decode(const Params& p, int it) {
    unsigned char* ws = p.ws; TrItem t; const int l = it / TR_PER; int r = it - l * TR_PER;
    if (r < TR_IN) { const int ct = r >> 4, kt = r & 15;
        t.src = p.w_in + (size_t)l * DM * NORIG; t.ld = NORIG; t.c0 = ct < 4 ? ct * 256 : 1040 + (ct - 4) * 256; t.k0 = kt * 64; t.ksc = p.norm_mix + l * DM;
        t.dst = (bf16_t*)(ws + WS_W1 + l * SZ_W1); t.ldd = DM; t.mode = 0; t.roff = ct < 4 ? 0 : 240; return t; }
    r -= TR_IN;
    if (r < TR_BR) { const int br = r >> 5, q = r & 31, ct = q >> 3, kt = q & 7;
        t.src = p.w_branch + ((size_t)l * 4 + br) * 512 * DM; t.ld = DM; t.c0 = ct * 256; t.k0 = kt * 64; t.ksc = nullptr;
        t.dst = (bf16_t*)(ws + WS_WB + l * SZ_WB) + (size_t)br * DM * 512; t.ldd = 512; t.mode = 0; t.roff = 0; return t; }
    r -= TR_BR;
    if (r < TR_OUT) { const int ct = r >> 4, kt = r & 15;
        t.src = p.w_out + (size_t)l * DM * DM; t.ld = DM; t.c0 = ct * 256; t.k0 = kt * 64; t.ksc = nullptr; t.dst = (bf16_t*)(ws + WS_WO + l * SZ_WO); t.ldd = DM; t.mode = 0; t.roff = 0; return t; }
    r -= TR_OUT;
    if (r < TR_G + TR_U) { const int up = r >= TR_G; const int q = up ? r - TR_G : r; const int ct = q >> 4, kt = q & 15;
        t.src = (up ? p.w_up : p.w_gate) + (size_t)l * DM * FF; t.ld = FF; t.c0 = ct * 256; t.k0 = kt * 64; t.ksc = p.norm_ffn + l * DM;
        t.dst = (bf16_t*)(ws + WS_WGU + l * SZ_WGU); t.ldd = DM; t.mode = up ? 2 : 1; t.roff = 0; return t; }
    r -= TR_G + TR_U;
    { const int ct = r / 44, kt = r - ct * 44;
        t.src = p.w_down + (size_t)l * FF * DM; t.ld = DM; t.c0 = ct * 256; t.k0 = kt * 64; t.ksc = nullptr; t.dst = (bf16_t*)(ws + WS_WD + l * SZ_WD); t.ldd = FF; t.mode = 0; t.roff = 0; return t; }
}
DI void tr_store(const TrItem& t, const float* sm, int tid) {
    const int k8 = (tid & 7) * 8;
#pragma unroll
    for (int q = 0; q < 4; ++q) { const int n2 = (tid >> 3) + 64 * q;
        u32x4 w; w.x = pk2(sm[(k8 + 0) * 257 + n2], sm[(k8 + 1) * 257 + n2]); w.y = pk2(sm[(k8 + 2) * 257 + n2], sm[(k8 + 3) * 257 + n2]);
        w.z = pk2(sm[(k8 + 4) * 257 + n2], sm[(k8 + 5) * 257 + n2]); w.w = pk2(sm[(k8 + 6) * 257 + n2], sm[(k8 + 7) * 257 + n2]);
        const int n = t.c0 + n2; int drow;
        if (t.mode == 0) { const int np = n + t.roff; drow = (np & ~255) + 128 * ((np >> 5) & 1) + 32 * ((np >> 6) & 3) + (np & 31); }
        else if (t.mode == 4) { const int np = n + t.roff; drow = (np & ~255) + 128 * ((np >> 3) & 1) + 32 * ((np >> 6) & 3) + 8 * ((np >> 4) & 3) + (np & 7); }
        else drow = 256 * (n >> 7) + 128 * ((n >> 2) & 1) + 32 * ((n >> 5) & 3) + (t.mode == 2 ? 16 : 0) + 4 * ((n >> 3) & 3) + (n & 3);
        *(u32x4*)(t.dst + (size_t)drow * t.ldd + t.k0 + k8) = w; }
}

DI void phase0(const Params& p, unsigned char* lds) {
    unsigned char* ws = p.ws;
    const int tid = opaque_tid();
    float* sm0 = (float*)lds; float* sm1 = sm0 + 64 * 257;
    const int G = gridDim.x, nn = tid & 255, kq = tid >> 8;
    for (int it = blockIdx.x; it < NL * TR_PER; it += 2 * G) {
        const bool two = it + G < NL * TR_PER;
        const TrItem a = tr_decode(p, it), b = tr_decode(p, two ? it + G : it);
        float va[32], vb[32];
#pragma unroll
        for (int i = 0; i < 32; ++i) va[i] = a.src[(size_t)(a.k0 + kq + 2 * i) * a.ld + a.c0 + nn];
        if (two) {
#pragma unroll
            for (int i = 0; i < 32; ++i) vb[i] = b.src[(size_t)(b.k0 + kq + 2 * i) * b.ld + b.c0 + nn]; }
        if (a.ksc) {
#pragma unroll
            for (int i = 0; i < 32; ++i) va[i] *= a.ksc[a.k0 + kq + 2 * i]; }
#pragma unroll
        for (int i = 0; i < 32; ++i) sm0[(kq + 2 * i) * 257 + nn] = va[i];
        if (two) {
            if (b.ksc) {
#pragma unroll
                for (int i = 0; i < 32; ++i) vb[i] *= b.ksc[b.k0 + kq + 2 * i]; }
#pragma unroll
            for (int i = 0; i < 32; ++i) sm1[(kq + 2 * i) * 257 + nn] = vb[i]; }
        __syncthreads();
        tr_store(a, sm0, tid);
        if (two) tr_store(b, sm1, tid);
        __syncthreads();
    }
    for (int g = blockIdx.x; g < NL * TR_GK; g += G) {
            const int l = g / TR_GK, r = g - l * TR_GK;
            const int j = 4 * r + (tid >> 7), k0 = (tid & 127) * 8;
            float wj[16];
#pragma unroll
            for (int q = 0; q < 16; ++q) wj[q] = p.a_w_gk[((size_t)l * 16 + q) * 256 + j];
            float o[8];
#pragma unroll
            for (int e = 0; e < 8; ++e) { const float* wr_ = p.w_in + ((size_t)l * DM + k0 + e) * NORIG + 1024; float s = 0.f;
#pragma unroll
                for (int q = 0; q < 16; ++q) s += wr_[q] * wj[q];
                o[e] = s * p.norm_mix[l * DM + k0 + e]; }
            u32x4 w; w.x = pk2(o[0], o[1]); w.y = pk2(o[2], o[3]); w.z = pk2(o[4], o[5]); w.w = pk2(o[6], o[7]);
            *(u32x4*)((bf16_t*)(ws + WS_W1 + l * SZ_W1) + (size_t)(1024 + 128 * ((j >> 5) & 1) + 32 * ((j >> 6) & 3) + (j & 31)) * DM + k0) = w;
    }
    float* ss = (float*)(ws + WS_SSP);
    bf16_t* hb = (bf16_t*)(ws + WS_HB);
    const int lane = tid & 63, gw = blockIdx.x * 8 + (tid >> 6), nw = gridDim.x * 8;
    for (int row = gw; row < T; row += nw) { float sq = 0.f;
#pragma unroll
        for (int i = 0; i < 4; ++i) { const size_t o = (size_t)row * DM + i * 256 + lane * 4; const f32x4 v = *(const f32x4*)(p.x + o);
            sq += v[0] * v[0] + v[1] * v[1] + v[2] * v[2] + v[3] * v[3]; u32x2 w; w.x = pk2(v[0], v[1]); w.y = pk2(v[2], v[3]); *(u32x2*)(hb + o) = w; }
#pragma unroll
        for (int s = 1; s < 64; s <<= 1) sq += __shfl_xor(sq, s);
        if (lane < 16) ss[(size_t)row * 16 + lane] = lane == 0 ? sq : 0.f; }
}

DI int p16(int k) { return 8 * ((k >> 2) & 1) + 4 * (k >> 3) + (k & 3); }

typedef short v4i16_t __attribute__((ext_vector_type(4)));
DI bf16x8 vtr8(const bf16_t* p) {
    const v4i16_t lo = __builtin_amdgcn_ds_read_tr16_b64_v4i16((LAS v4i16_t*)p), hi = __builtin_amdgcn_ds_read_tr16_b64_v4i16((LAS v4i16_t*)(p + 8 * 72));
    return __builtin_shufflevector(lo, hi, 0, 1, 2, 3, 4, 5, 6, 7);
}

DI void mixer_B(int job, const bf16_t* P1, const float* __restrict__ rel_tab, bf16_t* Yb, unsigned char* lds) {
    const int tid = opaque_tid(), lane = tid & 63, w = __builtin_amdgcn_readfirstlane(tid >> 6), j = lane & 31, hi = lane >> 5;
    const int cg4 = job & 7, h = (job >> 3) & 7, b = job >> 6;
    const int c = cg4 * 4 + (w >> 1);
    const int qt = c * 64 + (w & 1) * 32 + j;
    const size_t qrow = (size_t)b * SEQ + qt;
    bf16_t* Ks = (bf16_t*)lds;
    bf16_t* Vs = Ks + 2 * 64 * 72;
    float* tab = (float*)(Vs + 2 * 64 * 72);
    if (tid < 257) tab[tid] = rel_tab[h * 257 + tid] * 1.4426950408889634f;
    bf16x8 qf[4];
#pragma unroll
    for (int kk = 0; kk < 4; ++kk) qf[kk] = *(const bf16x8*)(P1 + qrow * LD1 + B_Q + h * 64 + kk * 16 + hi * 8);
    f32x16 O0, O1;
#pragma unroll
    for (int r = 0; r < 16; ++r) { O0[r] = 0.f; O1[r] = 0.f; }
    float m_run = -1e30f, l_run = 0.f;
    const int kc_lo = cg4 * 4 - 8 < 0 ? 0 : cg4 * 4 - 8, kc_hi = cg4 * 4 + 3;
    const int skey = tid >> 3, sdc = tid & 7;
    const int voff = (4 * hi + ((lane & 15) >> 2)) * 72 + 16 * ((lane >> 4) & 1) + 4 * (lane & 3);
    u32x4 kreg, vreg, kreg1, vreg1;
    { const size_t gr = ((size_t)b * SEQ + kc_lo * 64 + skey) * LD1 + h * 64 + sdc * 8; kreg = *(const u32x4*)(P1 + gr + B_K); vreg = *(const u32x4*)(P1 + gr + B_V);
      kreg1 = *(const u32x4*)(P1 + gr + (size_t)64 * LD1 + B_K); vreg1 = *(const u32x4*)(P1 + gr + (size_t)64 * LD1 + B_V); }
    for (int kc0 = kc_lo; kc0 <= kc_hi; kc0 += 2) {
#pragma unroll
      for (int sub = 0; sub < 2; ++sub) {
        const int kc = kc0 + sub, buf = sub;
        *(u32x4*)(Ks + (buf * 64 + skey) * 72 + sdc * 8) = sub ? kreg1 : kreg;
        *(u32x4*)(Vs + (buf * 64 + skey) * 72 + sdc * 8) = sub ? vreg1 : vreg;
        if (kc + 2 <= kc_hi) { const size_t gr = ((size_t)b * SEQ + (kc + 2) * 64 + skey) * LD1 + h * 64 + sdc * 8;
            if (sub) { kreg1 = *(const u32x4*)(P1 + gr + B_K); vreg1 = *(const u32x4*)(P1 + gr + B_V); } else { kreg = *(const u32x4*)(P1 + gr + B_K); vreg = *(const u32x4*)(P1 + gr + B_V); } }
        __syncthreads();
        if (kc >= c - 8 && kc <= c) {
            f32x16 s0, s1;
#pragma unroll
            for (int r = 0; r < 16; ++r) { s0[r] = 0.f; s1[r] = 0.f; }
#pragma unroll
            for (int kk = 0; kk < 4; ++kk) {
                const bf16x8 a0 = *(const bf16x8*)(Ks + (buf * 64 + j) * 72 + kk * 16 + hi * 8), a1 = *(const bf16x8*)(Ks + (buf * 64 + 32 + j) * 72 + kk * 16 + hi * 8);
                s0 = MFMA32(a0, qf[kk], s0); s1 = MFMA32(a1, qf[kk], s1); }
            const int relbase = qt - kc * 64 + 128;
            float mt = -1e30f;
            if (kc * 64 + 63 + 128 <= c * 64 + (w & 1) * 32) {
                const float bc = tab[256];
#pragma unroll
                for (int r = 0; r < 16; ++r) { s0[r] = s0[r] * 0.18033688011112042f + bc; s1[r] = s1[r] * 0.18033688011112042f + bc; mt = fmaxf(mt, fmaxf(s0[r], s1[r])); }
            } else {
#pragma unroll
            for (int r = 0; r < 16; ++r) { const int k0 = crow(r, hi);
                int i0 = relbase - k0; i0 = i0 < 0 ? 0 : (i0 > 256 ? 256 : i0);
                int i1 = relbase - 32 - k0; i1 = i1 < 0 ? 0 : (i1 > 256 ? 256 : i1);
                s0[r] = s0[r] * 0.18033688011112042f + tab[i0]; s1[r] = s1[r] * 0.18033688011112042f + tab[i1];
                mt = fmaxf(mt, fmaxf(s0[r], s1[r])); }
            }
            mt = fmaxf(mt, __shfl_xor(mt, 32));
            if (__any(mt > m_run + 8.f)) {
                const float mn = fmaxf(m_run, mt), alpha = __builtin_amdgcn_exp2f(m_run - mn); m_run = mn; l_run *= alpha;
#pragma unroll
                for (int r = 0; r < 16; ++r) { O0[r] *= alpha; O1[r] *= alpha; } }
            float ps = 0.f;
#pragma unroll
            for (int r = 0; r < 16; ++r) { s0[r] = __builtin_amdgcn_exp2f(s0[r] - m_run); s1[r] = __builtin_amdgcn_exp2f(s1[r] - m_run); ps += s0[r] + s1[r]; }
            ps += __shfl_xor(ps, 32);
            l_run += ps;
#pragma unroll
            for (int s = 0; s < 2; ++s) {
                u32x4 pw0, pw1;
                pw0.x = pk2(s0[8 * s + 0], s0[8 * s + 1]); pw0.y = pk2(s0[8 * s + 2], s0[8 * s + 3]); pw0.z = pk2(s0[8 * s + 4], s0[8 * s + 5]); pw0.w = pk2(s0[8 * s + 6], s0[8 * s + 7]);
                pw1.x = pk2(s1[8 * s + 0], s1[8 * s + 1]); pw1.y = pk2(s1[8 * s + 2], s1[8 * s + 3]); pw1.z = pk2(s1[8 * s + 4], s1[8 * s + 5]); pw1.w = pk2(s1[8 * s + 6], s1[8 * s + 7]);
                const bf16x8 pb0 = __builtin_bit_cast(bf16x8, pw0), pb1 = __builtin_bit_cast(bf16x8, pw1);
                const bf16x8 v00 = vtr8(Vs + (buf * 64 + s * 16) * 72 + voff), v01 = vtr8(Vs + (buf * 64 + s * 16) * 72 + 32 + voff);
                const bf16x8 v10 = vtr8(Vs + (buf * 64 + 32 + s * 16) * 72 + voff), v11 = vtr8(Vs + (buf * 64 + 32 + s * 16) * 72 + 32 + voff);
                O0 = MFMA32(v00, pb0, O0); O1 = MFMA32(v01, pb0, O1);
                O0 = MFMA32(v10, pb1, O0); O1 = MFMA32(v11, pb1, O1); }
        }
      }
    }
    const float inv = 1.f / l_run;
#pragma unroll
    for (int q = 0; q < 4; ++q) {
        u32x2 w0, w1; w0.x = pk2(O0[4 * q] * inv, O0[4 * q + 1] * inv); w0.y = pk2(O0[4 * q + 2] * inv, O0[4 * q + 3] * inv);
        w1.x = pk2(O1[4 * q] * inv, O1[4 * q + 1] * inv); w1.y = pk2(O1[4 * q + 2] * inv, O1[4 * q + 3] * inv);
        *(u32x2*)(Yb + qrow * 512 + h * 64 + 8 * q + 4 * hi) = w0; *(u32x2*)(Yb + qrow * 512 + h * 64 + 32 + 8 * q + 4 * hi) = w1; }
}

constexpr float DCUT = 2.3e-16f;
DI void mixer_D(int job, const bf16_t* P1, bf16_t* Yd, unsigned char* lds) {
    const int tid = opaque_tid(), lane = tid & 63, w = __builtin_amdgcn_readfirstlane(tid >> 6), j = lane & 31, hi = lane >> 5;
    const int qb = 7 - (job >> 6), bh = job & 63, b = bh >> 3, h = bh & 7;
    const int qt = qb * 256 + w * 32 + j;
    const size_t qrow = (size_t)b * SEQ + qt;
    bf16_t* Ks = (bf16_t*)lds;
    bf16_t* Vs = Ks + 2 * 64 * 72;
    volatile int* flags = (volatile int*)(Vs + 2 * 64 * 72);
    bf16x8 qf[4];
#pragma unroll
    for (int kk = 0; kk < 4; ++kk) qf[kk] = *(const bf16x8*)(P1 + qrow * LD1 + D_Q + h * 64 + kk * 16 + hi * 8);
    f32x16 O0, O1;
#pragma unroll
    for (int r = 0; r < 16; ++r) { O0[r] = 0.f; O1[r] = 0.f; }
    float carry = 1.f; bool alive = true;
    const int kt_hi = qb * 4 + 3, ktmax_w = qb * 4 + (w >> 1);
    const int skey = tid >> 3, sdc = tid & 7;
    const int voff = (4 * hi + ((lane & 15) >> 2)) * 72 + 16 * ((lane >> 4) & 1) + 4 * (lane & 3);
    u32x4 kreg, vreg, kreg1, vreg1;
    { const size_t gr = ((size_t)b * SEQ + kt_hi * 64 + skey) * LD1 + h * 64 + sdc * 8; kreg = *(const u32x4*)(P1 + gr + D_K); vreg = *(const u32x4*)(P1 + gr + D_V);
      kreg1 = *(const u32x4*)(P1 + gr - (size_t)64 * LD1 + D_K); vreg1 = *(const u32x4*)(P1 + gr - (size_t)64 * LD1 + D_V); }
    bool stop = false;
    for (int kt0 = kt_hi; kt0 >= 0 && !stop; kt0 -= 2) {
#pragma unroll
      for (int sub = 0; sub < 2; ++sub) {
        const int kt = kt0 - sub, buf = sub;
        *(u32x4*)(Ks + (buf * 64 + skey) * 72 + sdc * 8) = sub ? kreg1 : kreg;
        *(u32x4*)(Vs + (buf * 64 + skey) * 72 + sdc * 8) = sub ? vreg1 : vreg;
        if (lane == 0) flags[buf * 8 + w] = alive ? 1 : 0;
        if (kt >= 2) { const size_t gr = ((size_t)b * SEQ + (kt - 2) * 64 + skey) * LD1 + h * 64 + sdc * 8;
            if (sub) { kreg1 = *(const u32x4*)(P1 + gr + D_K); vreg1 = *(const u32x4*)(P1 + gr + D_V); } else { kreg = *(const u32x4*)(P1 + gr + D_K); vreg = *(const u32x4*)(P1 + gr + D_V); } }
        __syncthreads();
        int any = 0;
#pragma unroll
        for (int q = 0; q < 8; ++q) any |= flags[buf * 8 + q];
        if (!any) { stop = true; break; }
        if (alive && kt <= ktmax_w) {
            f32x16 s0, s1;
#pragma unroll
            for (int r = 0; r < 16; ++r) { s0[r] = 0.f; s1[r] = 0.f; }
#pragma unroll
            for (int kk = 0; kk < 4; ++kk) {
                const bf16x8 a0 = *(const bf16x8*)(Ks + (buf * 64 + j) * 72 + kk * 16 + hi * 8), a1 = *(const bf16x8*)(Ks + (buf * 64 + 32 + j) * 72 + kk * 16 + hi * 8);
                s0 = MFMA32(a0, qf[kk], s0); s1 = MFMA32(a1, qf[kk], s1); }
#pragma unroll
            for (int kb = 1; kb >= 0; --kb) {
                f32x16& sx = kb ? s1 : s0;
                const int kbase = kt * 64 + kb * 32;
                float sg[16], rr[16]; float gp[4];
#pragma unroll
                for (int q = 0; q < 4; ++q) { gp[q] = 1.f;
#pragma unroll
                    for (int m = 0; m < 4; ++m) { const int r = 4 * q + m;
                        const float e = __builtin_amdgcn_exp2f(fminf(sx[r] * 0.18033688011112042f, 115.4156f));
                        const float ri = __builtin_amdgcn_rcpf(1.f + e);
                        const bool masked = (kbase + crow(r, hi)) >= qt;
                        rr[r] = masked ? 1.f : ri; sg[r] = masked ? 0.f : e * ri; gp[q] *= rr[r]; } }
                float tq[4], tot[4];
#pragma unroll
                for (int q = 0; q < 4; ++q) { tq[q] = __shfl_xor(gp[q], 32); tot[q] = gp[q] * tq[q]; }
                float after = 1.f;
#pragma unroll
                for (int q = 3; q >= 0; --q) {
                    float run = carry * after * (hi == 0 ? tq[q] : 1.f);
#pragma unroll
                    for (int m = 3; m >= 0; --m) { const int r = 4 * q + m; sx[r] = sg[r] * run; run *= rr[r]; }
                    after *= tot[q]; }
                carry *= after;
            }
#pragma unroll
            for (int s = 0; s < 2; ++s) {
                u32x4 pw0, pw1;
                pw0.x = pk2(s0[8 * s + 0], s0[8 * s + 1]); pw0.y = pk2(s0[8 * s + 2], s0[8 * s + 3]); pw0.z = pk2(s0[8 * s + 4], s0[8 * s + 5]); pw0.w = pk2(s0[8 * s + 6], s0[8 * s + 7]);
                pw1.x = pk2(s1[8 * s + 0], s1[8 * s + 1]); pw1.y = pk2(s1[8 * s + 2], s1[8 * s + 3]); pw1.z = pk2(s1[8 * s + 4], s1[8 * s + 5]); pw1.w = pk2(s1[8 * s + 6], s1[8 * s + 7]);
                const bf16x8 pb0 = __builtin_bit_cast(bf16x8, pw0), pb1 = __builtin_bit_cast(bf16x8, pw1);
                const bf16x8 v00 = vtr8(Vs + (buf * 64 + s * 16) * 72 + voff), v01 = vtr8(Vs + (buf * 64 + s * 16) * 72 + 32 + voff);
                const bf16x8 v10 = vtr8(Vs + (buf * 64 + 32 + s * 16) * 72 + voff), v11 = vtr8(Vs + (buf * 64 + 32 + s * 16) * 72 + 32 + voff);
                O0 = MFMA32(v00, pb0, O0); O1 = MFMA32(v01, pb0, O1);
                O0 = MFMA32(v10, pb1, O0); O1 = MFMA32(v11, pb1, O1); }
            alive = __any(carry >= DCUT) != 0;
        }
      }
    }
#pragma unroll
    for (int q = 0; q < 4; ++q) {
        u32x2 w0, w1; w0.x = pk2(O0[4 * q], O0[4 * q + 1]); w0.y = pk2(O0[4 * q + 2], O0[4 * q + 3]);
        w1.x = pk2(O1[4 * q], O1[4 * q + 1]); w1.y = pk2(O1[4 * q + 2], O1[4 * q + 3]);
        *(u32x2*)(Yd + qrow * 512 + h * 64 + 8 * q + 4 * hi) = w0; *(u32x2*)(Yd + qrow * 512 + h * 64 + 32 + 8 * q + 4 * hi) = w1; }
}

DI void mixer_A(int job, const bf16_t* P1, const float* __restrict__ bgk, const float* __restrict__ anorm, bf16_t* Ya, unsigned char* lds) {
    const int tid = opaque_tid(), lane = tid & 63, w = __builtin_amdgcn_readfirstlane(tid >> 6), j = lane & 31, hi = lane >> 5;
    const int b = job >> 2, h = job & 3;
    float* GK = (float*)lds;
    float* SEG = GK + 64 * 65;
    float* TOT = SEG + 512;
    bf16_t* Kb = (bf16_t*)(TOT + 64);
    bf16_t* Qs = Kb + 64 * 64;
    bf16_t* KDT = Qs + 64 * 72;
    bf16_t* VT = KDT + 64 * 72;
    float* Ys = (float*)(VT + 128 * 72);
    const int lt = tid >> 3, c8 = tid & 7;
    const int kx = tid & 63, seg = tid >> 6;
    f32x16 X;
#pragma unroll
    for (int r = 0; r < 16; ++r) X[r] = 0.f;
    float an[16];
#pragma unroll
    for (int e = 0; e < 16; ++e) an[e] = anorm[(e >> 3) * 64 + (tid & 7) * 8 + (e & 7)];
    float bg[8];
#pragma unroll
    for (int e = 0; e < 8; ++e) bg[e] = bgk[h * 64 + c8 * 8 + e];
    u32x4 rq, rk, rg, rv0, rv1;
    { const bf16_t* rp = P1 + ((size_t)b * SEQ + lt) * LD1;
      rq = *(const u32x4*)(rp + A_Q + h * 64 + c8 * 8); rk = *(const u32x4*)(rp + A_K + h * 64 + c8 * 8); rg = *(const u32x4*)(rp + A_GK + h * 64 + c8 * 8);
      rv0 = *(const u32x4*)(rp + A_V + h * 128 + c8 * 8); rv1 = *(const u32x4*)(rp + A_V + h * 128 + 64 + c8 * 8); }
    for (int c = 0; c < 32; ++c) {
        *(u32x4*)(Qs + lt * 72 + c8 * 8) = rq; *(u32x4*)(Kb + lt * 64 + c8 * 8) = rk;
#pragma unroll
        for (int e = 0; e < 4; ++e) { const float x0 = bflo(rg[e]) + bg[2 * e], x1 = bfhi(rg[e]) + bg[2 * e + 1];
            GK[lt * 65 + c8 * 8 + 2 * e] = (fminf(x0, 0.f) - __logf(1.f + __expf(-fabsf(x0)))) * (1.f / 16.f);
            GK[lt * 65 + c8 * 8 + 2 * e + 1] = (fminf(x1, 0.f) - __logf(1.f + __expf(-fabsf(x1)))) * (1.f / 16.f); }
        *(u32x4*)(VT + lt * 136 + c8 * 8) = rv0; *(u32x4*)(VT + lt * 136 + 64 + c8 * 8) = rv1;
        const size_t grow_ = (size_t)b * SEQ + c * 64 + (tid >> 3);
        const u32x4 g0 = *(const u32x4*)(P1 + grow_ * LD1 + A_G + h * 128 + (tid & 7) * 8), g1 = *(const u32x4*)(P1 + grow_ * LD1 + A_G + h * 128 + 64 + (tid & 7) * 8);
        if (c < 31) { const bf16_t* rp = P1 + ((size_t)b * SEQ + (c + 1) * 64 + lt) * LD1;
            rq = *(const u32x4*)(rp + A_Q + h * 64 + c8 * 8); rk = *(const u32x4*)(rp + A_K + h * 64 + c8 * 8); rg = *(const u32x4*)(rp + A_GK + h * 64 + c8 * 8);
            rv0 = *(const u32x4*)(rp + A_V + h * 128 + c8 * 8); rv1 = *(const u32x4*)(rp + A_V + h * 128 + 64 + c8 * 8); }
        __syncthreads();
        float cum[8]; { float run = 0.f;
#pragma unroll
            for (int i = 0; i < 8; ++i) { run += GK[(8 * seg + i) * 65 + kx]; cum[i] = run; }
            SEG[seg * 64 + kx] = run; }
        __syncthreads();
        { float off = 0.f, total = 0.f;
#pragma unroll
          for (int s = 0; s < 8; ++s) { const float v = SEG[s * 64 + kx]; total += v; if (s < seg) off += v; }
          float kd[8];
#pragma unroll
          for (int i = 0; i < 8; ++i) kd[i] = bf2f(Kb[(8 * seg + i) * 64 + kx]) * __expf(total - (off + cum[i]));
          u32x4 wv; wv.x = pk2(kd[0], kd[1]); wv.y = pk2(kd[2], kd[3]); wv.z = pk2(kd[4], kd[5]); wv.w = pk2(kd[6], kd[7]);
          *(u32x4*)(KDT + kx * 72 + 8 * seg) = wv;
          if (seg == 0) TOT[kx] = __expf(total); }
        __syncthreads();
        { const int kb = w & 1, vb = w >> 1;
#pragma unroll
          for (int r = 0; r < 16; ++r) X[r] *= TOT[32 * kb + crow(r, hi)];
#pragma unroll
          for (int kk = 0; kk < 4; ++kk) { const bf16x8 a = *(const bf16x8*)(KDT + (32 * kb + j) * 72 + kk * 16 + hi * 8);
              const bf16_t* vp = VT + (16 * kk + 8 * hi + ((lane & 15) >> 2)) * 136 + 32 * vb + 16 * ((lane >> 4) & 1) + 4 * (lane & 3);
              const v4i16_t lo = __builtin_amdgcn_ds_read_tr16_b64_v4i16((LAS v4i16_t*)vp), hi4 = __builtin_amdgcn_ds_read_tr16_b64_v4i16((LAS v4i16_t*)(vp + 4 * 136));
              const bf16x8 bb = __builtin_shufflevector(lo, hi4, 0, 1, 2, 3, 4, 5, 6, 7);
              X = MFMA32(a, bb, X); }
          u32x4 xw0, xw1;
          xw0.x = pk2(X[0], X[1]); xw0.y = pk2(X[2], X[3]); xw0.z = pk2(X[4], X[5]); xw0.w = pk2(X[6], X[7]);
          xw1.x = pk2(X[8], X[9]); xw1.y = pk2(X[10], X[11]); xw1.z = pk2(X[12], X[13]); xw1.w = pk2(X[14], X[15]);
          const bf16x8 xs0 = __builtin_bit_cast(bf16x8, xw0), xs1 = __builtin_bit_cast(bf16x8, xw1);
#pragma unroll
          for (int tb = 0; tb < 2; ++tb) { f32x16 Y;
#pragma unroll
              for (int r = 0; r < 16; ++r) Y[r] = 0.f;
#pragma unroll
              for (int s2 = 0; s2 < 2; ++s2) { const bf16_t* qp = Qs + (32 * tb + j) * 72 + 32 * kb + 16 * s2 + 4 * hi;
                  const u32x2 qlo = *(const u32x2*)qp, qhi = *(const u32x2*)(qp + 8);
                  u32x4 qa; qa.x = qlo.x; qa.y = qlo.y; qa.z = qhi.x; qa.w = qhi.y;
                  Y = MFMA32(__builtin_bit_cast(bf16x8, qa), s2 ? xs1 : xs0, Y); }
#pragma unroll
              for (int r = 0; r < 16; ++r) Ys[(kb * 64 + 32 * tb + crow(r, hi)) * 132 + 32 * vb + j] = Y[r] * 0.125f; } }
        __syncthreads();
        { const int t = tid >> 3, vs = tid & 7; float y[16]; float sq = 0.f;
#pragma unroll
          for (int i = 0; i < 4; ++i) { const int cy = (i >> 1) * 64 + vs * 8 + 4 * (i & 1); const f32x4 v = *(const f32x4*)(Ys + t * 132 + cy) + *(const f32x4*)(Ys + (64 + t) * 132 + cy); y[4 * i] = v[0]; y[4 * i + 1] = v[1]; y[4 * i + 2] = v[2]; y[4 * i + 3] = v[3];
              sq += v[0] * v[0] + v[1] * v[1] + v[2] * v[2] + v[3] * v[3]; }
          sq += __shfl_xor(sq, 1); sq += __shfl_xor(sq, 2); sq += __shfl_xor(sq, 4);
          const float rs = rsqrtf(sq * (1.f / 128.f) + EPS);
          const size_t row = (size_t)b * SEQ + c * 64 + t;
          float o[16];
#pragma unroll
          for (int e = 0; e < 4; ++e) { const float ga = bflo(g0[e]), gb = bfhi(g0[e]), gc = bflo(g1[e]), gd = bfhi(g1[e]);
              o[2 * e] = y[2 * e] * rs * an[2 * e] * (ga * __builtin_amdgcn_rcpf(1.f + __expf(-ga)));
              o[2 * e + 1] = y[2 * e + 1] * rs * an[2 * e + 1] * (gb * __builtin_amdgcn_rcpf(1.f + __expf(-gb)));
              o[8 + 2 * e] = y[8 + 2 * e] * rs * an[8 + 2 * e] * (gc * __builtin_amdgcn_rcpf(1.f + __expf(-gc)));
              o[8 + 2 * e + 1] = y[8 + 2 * e + 1] * rs * an[8 + 2 * e + 1] * (gd * __builtin_amdgcn_rcpf(1.f + __expf(-gd))); }
          u32x4 w0, w1; w0.x = pk2(o[0], o[1]); w0.y = pk2(o[2], o[3]); w0.z = pk2(o[4], o[5]); w0.w = pk2(o[6], o[7]);
          w1.x = pk2(o[8], o[9]); w1.y = pk2(o[10], o[11]); w1.z = pk2(o[12], o[13]); w1.w = pk2(o[14], o[15]);
          *(u32x4*)(Ya + row * 512 + h * 128 + vs * 8) = w0; *(u32x4*)(Ya + row * 512 + h * 128 + 64 + vs * 8) = w1; }
    }
}

DI void mixer_C(int job, const bf16_t* P1, const float* __restrict__ conv_w, const float* __restrict__ conv_b, const float* __restrict__ w_a, const float* __restrict__ b_a,
                const float* __restrict__ w_x, const float* __restrict__ b_x, const float* __restrict__ lam, bf16_t* Yc, unsigned char* lds) {
    const int tid = opaque_tid(), lane = tid & 63, w = __builtin_amdgcn_readfirstlane(tid >> 6), j = lane & 31, hi = lane >> 5;
    const int b = job >> 3, g = job & 7;
    bf16_t* XC = (bf16_t*)lds;
    bf16_t* WA = XC + 64 * 72;
    bf16_t* WX = WA + 64 * 72;
    float* RI = (float*)(WX + 64 * 72);
    float* SEGA = RI + 2 * 64 * 65;
    float* SEGH = SEGA + 512;
    const int ch = tid & 63, seg = tid >> 6, cc = g * 64 + ch;
#pragma unroll
    for (int n = 0; n < 8; ++n) { const int idx = tid + 512 * n, i = idx >> 6, jj = idx & 63;
        WA[jj * 72 + i] = f2bf(w_a[(size_t)g * 4096 + idx]); WX[jj * 72 + i] = f2bf(w_x[(size_t)g * 4096 + idx]); }
    const float cw0 = conv_w[cc], cw1 = conv_w[512 + cc], cw2 = conv_w[1024 + cc], cw3 = conv_w[1536 + cc], cb = conv_b[cc];
    const float ba = b_a[cc], bxb = b_x[cc], spl = log1pf(expf(-lam[cc]));
    float hcar = 0.f;
    bf16_t* XIN = (bf16_t*)(SEGH + 512);
    bf16_t* GIN = XIN + 2 * 67 * 64;
    bf16_t* YOUT = GIN + 2 * 64 * 64;
    const int lt = tid >> 3, c8 = tid & 7;
    const bf16_t* xg = P1 + (size_t)b * SEQ * LD1 + C_X + g * 64 + c8 * 8;
    const bf16_t* gg = P1 + (size_t)b * SEQ * LD1 + C_G + g * 64 + c8 * 8;
    u32x4 rx, rh, rg;
    { const u32x4 x0 = *(const u32x4*)(xg + (size_t)lt * LD1), g0 = *(const u32x4*)(gg + (size_t)lt * LD1);
      *(u32x4*)(XIN + (3 + lt) * 64 + c8 * 8) = x0; *(u32x4*)(GIN + lt * 64 + c8 * 8) = g0;
      if (tid < 24) *(u32x4*)(XIN + (tid >> 3) * 64 + c8 * 8) = (u32x4){0u, 0u, 0u, 0u};
      rx = *(const u32x4*)(xg + (size_t)(64 + lt) * LD1); rg = *(const u32x4*)(gg + (size_t)(64 + lt) * LD1);
      rh = rx; if (tid < 24) rh = *(const u32x4*)(xg + (size_t)(61 + (tid >> 3)) * LD1); }
    __syncthreads();
    for (int tt = 0; tt < 32; ++tt) {
        const int t0 = tt * 64 + seg * 8, buf = tt & 1;
        float xl[11], gv[8];
#pragma unroll
        for (int m = 0; m < 11; ++m) xl[m] = bf2f(XIN[(buf * 67 + seg * 8 + m) * 64 + ch]);
#pragma unroll
        for (int i = 0; i < 8; ++i) gv[i] = bf2f(GIN[(buf * 64 + seg * 8 + i) * 64 + ch]);
        if (tt < 31) { *(u32x4*)(XIN + ((buf ^ 1) * 67 + 3 + lt) * 64 + c8 * 8) = rx; *(u32x4*)(GIN + ((buf ^ 1) * 64 + lt) * 64 + c8 * 8) = rg;
            if (tid < 24) *(u32x4*)(XIN + ((buf ^ 1) * 67 + (tid >> 3)) * 64 + c8 * 8) = rh; }
        if (tt < 30) { const size_t tn = (size_t)(tt + 2) * 64;
            rx = *(const u32x4*)(xg + (tn + lt) * LD1); rg = *(const u32x4*)(gg + (tn + lt) * LD1);
            if (tid < 24) rh = *(const u32x4*)(xg + (tn - 3 + (tid >> 3)) * LD1); }
        float xc[8];
#pragma unroll
        for (int i = 0; i < 8; ++i) { xc[i] = cb + cw0 * xl[i] + cw1 * xl[i + 1] + cw2 * xl[i + 2] + cw3 * xl[i + 3]; XC[(seg * 8 + i) * 72 + ch] = f2bf(xc[i]); }
        __syncthreads();
        if (tt > 0) *(u32x4*)(Yc + ((size_t)b * SEQ + (tt - 1) * 64 + lt) * 512 + g * 64 + c8 * 8) = *(const u32x4*)(YOUT + lt * 64 + c8 * 8);
        { const int mat = w & 1, jb = (w >> 1) & 1, tb = w >> 2; const bf16_t* WM = mat ? WX : WA; f32x16 R;
#pragma unroll
          for (int r = 0; r < 16; ++r) R[r] = 0.f;
#pragma unroll
          for (int kk = 0; kk < 4; ++kk) { const bf16x8 a = *(const bf16x8*)(XC + (32 * tb + j) * 72 + kk * 16 + hi * 8), bb = *(const bf16x8*)(WM + (32 * jb + j) * 72 + kk * 16 + hi * 8);
              R = MFMA32(a, bb, R); }
#pragma unroll
          for (int r = 0; r < 16; ++r) RI[mat * 4160 + (32 * tb + crow(r, hi)) * 65 + 32 * jb + j] = R[r]; }
        __syncthreads();
        float hl[8], pp[8]; { float hh = 0.f, pr = 1.f;
#pragma unroll
          for (int i = 0; i < 8; ++i) { const float rv = __builtin_amdgcn_rcpf(1.f + __expf(-(RI[(seg * 8 + i) * 65 + ch] + ba))), iv = __builtin_amdgcn_rcpf(1.f + __expf(-(RI[4160 + (seg * 8 + i) * 65 + ch] + bxb)));
              const float la = -8.f * rv * spl, a = __expf(la), x2 = 2.f * la;
              const float ser = -x2 * (1.f + x2 * 0.5f * (1.f + x2 * (1.f / 3.f) * (1.f + x2 * 0.25f * (1.f + x2 * 0.2f))));
              const float om = x2 > -0.1f ? ser : 1.f - a * a;
              const float mult = __builtin_amdgcn_sqrtf(fmaxf(om, 0.f)), bx = mult * (iv * xc[i]);
              hh = a * hh + bx; pr *= a; hl[i] = hh; pp[i] = pr; }
          SEGA[seg * 64 + ch] = pr; SEGH[seg * 64 + ch] = hh; }
        __syncthreads();
        float hc = hcar, hf = hcar;
#pragma unroll
        for (int s = 0; s < 8; ++s) { const float sa = SEGA[s * 64 + ch], sh = SEGH[s * 64 + ch]; hf = sa * hf + sh; if (s < seg) hc = sa * hc + sh; }
        hcar = hf;
#pragma unroll
        for (int i = 0; i < 8; ++i) { const float hv = hl[i] + pp[i] * hc; const float x = gv[i];
            const float u = 0.7978845608f * (x + 0.044715f * x * x * x); const float th = 1.f - 2.f * __builtin_amdgcn_rcpf(1.f + __expf(2.f * u));
            YOUT[(seg * 8 + i) * 64 + ch] = f2bf(0.5f * x * (1.f + th) * hv); }
    }
    __syncthreads();
    *(u32x4*)(Yc + ((size_t)b * SEQ + 31 * 64 + lt) * 512 + g * 64 + c8 * 8) = *(const u32x4*)(YOUT + lt * 64 + c8 * 8);
}

DI void rs_fill(LAS float* rst, const float* ssp, int grp) {
    const int tid = opaque_tid();
#pragma unroll
    for (int i = 0; i < 4; ++i) { const int r = tid + 512 * i; rst[r] = rsqrtf(ss_row(ssp, grp * 2048 + r) * (1.f / 1024.f) + EPS); }
    __syncthreads();
}

#ifndef RA
#define RA 1
#endif
#ifndef RC
#define RC 1
#endif
#ifndef RD
#define RD 1
#endif
#ifndef RB
#define RB 1
#endif
constexpr int NJ_A = 32 * RA, NJ_C = 64 * RC, NJ_D = 512 * RD, NJ_B = 512 * RB, NJOBS = NJ_A + NJ_C + NJ_D + NJ_B;

__global__ void __launch_bounds__(512, 2) fwd_megakernel(Params p) {
    extern __shared__ __attribute__((aligned(16))) unsigned char lds[];
    cg::grid_group grid = cg::this_grid();
    unsigned char* ws = p.ws;
    LAS unsigned char* llds = (LAS unsigned char*)lds;
    const int G = gridDim.x, tid = threadIdx.x;
    float* ss = (float*)(ws + WS_SSP);
    bf16_t* P1 = (bf16_t*)(ws + WS_P1); bf16_t* P2 = (bf16_t*)(ws + WS_P2); bf16_t* Y = (bf16_t*)(ws + WS_Y); bf16_t* HB = (bf16_t*)(ws + WS_HB);
    bf16_t* MX = P1;
    bf16_t* U = P1;
    unsigned* jobctr = (unsigned*)(ws + WS_CTL);
    if (tid < 2) ((volatile LAS unsigned*)(llds + XBST))[tid] = 0u;
    __syncthreads();
    const XcdBarrier xbar = xcd_barrier_post((unsigned*)(ws + WS_BAR), (volatile LAS unsigned*)(llds + XBST));
#define GSYNC() xcd_barrier(xbar)

#ifndef NO_P0
    for (int rep = 0; rep < REP_P0; ++rep) { if (rep) grid.sync(); phase0(p, lds); }
#endif
    if (gridDim.y == 7u) grid.sync();
    GSYNC();

    for (int l = 0; l < NL; ++l) {
#ifndef NO_G1
        for (int rep = 0; rep < REP_G1; ++rep) {
            if (rep) GSYNC();
            pg8::Gemm g{HB, (const bf16_t*)(ws + WS_W1 + l * SZ_W1), T, NIN, DM, 0, 0, 1}; pg8::StaticOrder S; S.init(T, NIN, G, (int)blockIdx.x, 1);
            rs_fill((LAS float*)(llds + RS_OFF), ss + (size_t)(2 * l) * T * 16, (int)blockIdx.x & 7);
            pg8::EpiProj E{P1, P2, (const LAS float*)(llds + RS_OFF)};
            pg8::gemm_phase<pg8::EpiProj, true>(llds, g, S, E);
        }
#endif
        GSYNC();
        for (int rep = 0; rep < REP_MIX; ++rep) {
            if (rep) GSYNC();
            for (;;) {
                __syncthreads();
                if (tid == 0) *(volatile int*)(lds + JOBSLOT) = (int)atomicAdd(jobctr + l + 4 * rep, 1u);
                __syncthreads();
                const int job = *(volatile int*)(lds + JOBSLOT);
                if (job >= NJOBS) break;
#ifndef NO_MA
                if (job < NJ_A) mixer_A(job % 32, P1, p.a_b_gk + l * 256, p.a_norm + l * 128, Y, lds);
                else
#endif
#ifndef NO_MC
                if (job < NJ_A + NJ_C) mixer_C((job - NJ_A) % 64, P1, p.c_conv_w + l * 2048, p.c_conv_b + l * 512, p.c_w_a + (size_t)l * 32768, p.c_b_a + l * 512, p.c_w_x + (size_t)l * 32768, p.c_b_x + l * 512, p.c_lambda + l * 512, Y + (size_t)2 * T * 512, lds);
                else
#endif
#ifndef NO_MD
                if (job < NJ_A + NJ_C + NJ_D) mixer_D((job - NJ_A - NJ_C) % 512, P1, Y + (size_t)3 * T * 512, lds);
                else
#endif
#ifndef NO_MB
                mixer_B((job - NJ_A - NJ_C - NJ_D) % 512, P1, p.b_rel + l * 8 * 257, Y + (size_t)1 * T * 512, lds);
#endif
                ;
            }
        }
        GSYNC();
#ifndef NO_G3
        for (int rep = 0; rep < REP_G3; ++rep) {
            if (rep) GSYNC();
            pg8::Gemm g{Y, (const bf16_t*)(ws + WS_WB + l * SZ_WB), T, DM, 512, (size_t)T * 512 * 2, (size_t)DM * 512 * 2, 4}; pg8::StaticOrder S; S.init(T, DM, G, (int)blockIdx.x, 4);
            pg8::EpiMerge E{P2, MX};
            pg8::gemm_phase<pg8::EpiMerge, true>(llds, g, S, E);
        }
#endif
        GSYNC();
#ifndef NO_G4
        {
            pg8::Gemm g{MX, (const bf16_t*)(ws + WS_WO + l * SZ_WO), T, DM, DM, 0, 0, 1}; pg8::StaticOrder S; S.init(T, DM, G, (int)blockIdx.x, 1);
            pg8::EpiResid E{l == 0 ? p.x : nullptr, (const bf16_t*)p.out  , nullptr, Y  , HB, ss + (size_t)(2 * l + 1) * T * 16};
            pg8::gemm_phase<pg8::EpiResid, true>(llds, g, S, E);
        }
#endif
        GSYNC();
#ifdef XSYNC
        for (int q = 0; q < XSYNC; ++q) GSYNC();
#endif
#ifndef NO_G5
        for (int rep = 0; rep < REP_G5; ++rep) {
            if (rep) GSYNC();
            pg8::Gemm g{HB, (const bf16_t*)(ws + WS_WGU + l * SZ_WGU), T, NGU, DM, 0, 0, 1}; pg8::StaticOrder S; S.init(T, NGU, G, (int)blockIdx.x, 1);
            rs_fill((LAS float*)(llds + RS_OFF), ss + (size_t)(2 * l + 1) * T * 16, (int)blockIdx.x & 7);
            pg8::EpiFfn E{U, (const LAS float*)(llds + RS_OFF)};
            pg8::gemm_phase<pg8::EpiFfn, true>(llds, g, S, E);
        }
#endif
        GSYNC();
#ifndef NO_G6
        {
            pg8::Gemm g{U, (const bf16_t*)(ws + WS_WD + l * SZ_WD), T, DM, FF, 0, 0, 1}; pg8::StaticOrder S; S.init(T, DM, G, (int)blockIdx.x, 1);
            pg8::EpiResid E{nullptr, Y, l == NL - 1 ? p.out : nullptr, (bf16_t*)p.out, HB, ss + (size_t)(2 * l + 2) * T * 16};
            pg8::gemm_phase<pg8::EpiResid, true>(llds, g, S, E);
        }
#endif
        GSYNC();
    }
    {
        const int lane = tid & 63, gw = blockIdx.x * 8 + (tid >> 6), nw = G * 8; const float* ssf = ss + (size_t)8 * T * 16;
        for (int row = gw; row < T; row += nw) { const float rs = rsqrtf(ss_row(ssf, row) * (1.f / 1024.f) + EPS);
#pragma unroll
            for (int i = 0; i < 4; ++i) { const size_t o = (size_t)row * DM + i * 256 + lane * 4; f32x4 v = *(const f32x4*)(p.out + o); const f32x4 gn = *(const f32x4*)(p.norm_final + i * 256 + lane * 4);
                v[0] *= rs * gn[0]; v[1] *= rs * gn[1]; v[2] *= rs * gn[2]; v[3] *= rs * gn[3]; *(f32x4*)(p.out + o) = v; } }
    }
}

extern "C" void kernel_launch(void* const* d_in, const int* in_sizes, int n_in, void* d_out, int out_size, void* d_ws, size_t ws_size, hipStream_t stream) {
    static int grid_blocks = 0;
    if (grid_blocks == 0) {
        if (n_in != 21 || out_size != T * DM || ws_size < WS_END) { fprintf(stderr, "kernel_launch: unexpected shapes (n_in %d out %d ws %zu need %zu)\n", n_in, out_size, ws_size, (size_t)WS_END); grid_blocks = -1; return; }
        int dev = 0, cus = 0, per_cu = 0;
        hipGetDevice(&dev);
        hipDeviceGetAttribute(&cus, hipDeviceAttributeMultiprocessorCount, dev);
        if (hipFuncSetAttribute((const void*)fwd_megakernel, hipFuncAttributeMaxDynamicSharedMemorySize, LDS_BYTES) != hipSuccess) { fprintf(stderr, "kernel_launch: hipFuncSetAttribute failed\n"); grid_blocks = -1; return; }
        if (hipOccupancyMaxActiveBlocksPerMultiprocessor(&per_cu, (const void*)fwd_megakernel, 512, LDS_BYTES) != hipSuccess || per_cu < 1) { fprintf(stderr, "kernel_launch: occupancy query failed (%d)\n", per_cu); per_cu = 1; }
        (void)hipGetLastError();
        grid_blocks = cus * per_cu;
    }
    if (grid_blocks < 0) return;
    Params p{};
    p.x = (const float*)d_in[0]; p.norm_mix = (const float*)d_in[1]; p.w_in = (const float*)d_in[2]; p.a_w_gk = (const float*)d_in[3]; p.a_b_gk = (const float*)d_in[4]; p.a_norm = (const float*)d_in[5];
    p.b_rel = (const float*)d_in[6]; p.c_conv_w = (const float*)d_in[7]; p.c_conv_b = (const float*)d_in[8]; p.c_w_a = (const float*)d_in[9]; p.c_b_a = (const float*)d_in[10]; p.c_w_x = (const float*)d_in[11];
    p.c_b_x = (const float*)d_in[12]; p.c_lambda = (const float*)d_in[13]; p.w_branch = (const float*)d_in[14]; p.w_out = (const float*)d_in[15]; p.norm_ffn = (const float*)d_in[16];
    p.w_gate = (const float*)d_in[17]; p.w_up = (const float*)d_in[18]; p.w_down = (const float*)d_in[19]; p.norm_final = (const float*)d_in[20];
    p.out = (float*)d_out; p.ws = (unsigned char*)d_ws;
    if (hipMemsetAsync((char*)d_ws + WS_CTL, 0, CTL_ZERO_BYTES, stream) != hipSuccess) { fprintf(stderr, "kernel_launch: memset failed\n"); return; }
    void* args[] = {&p};
    hipError_t e = hipLaunchCooperativeKernel((const void*)fwd_megakernel, dim3(grid_blocks), dim3(512), args, LDS_BYTES, stream);
    if (e != hipSuccess) fprintf(stderr, "cooperative launch failed: %s (grid %d)\n", hipGetErrorString(e), grid_blocks);
}
```
